# Optimizing an MI355X kernel written in HIP

```python
import jax, jax.numpy as jnp
from jax import lax
import numpy as np

D_MODEL = 1024
BATCH = 4
SEQ = 4096
DEPTH = 2
DEC_BATCH = 8
DEC_SEQ = 64
PAST_LEN = 2048

CHUNK = 64
N_META = 16
PADF = CHUNK - N_META
A_HEADS = 8
A_KV_HEADS = 2
HEAD_DIM = 64
WINDOW = 128
WIN_CHUNKS = WINDOW // CHUNK
B_WIDTH = 512
B_CONV = 3
C_WIDTH = 512
C_CONV = 31
D_HEADS = 4
D_KEY = 128
D_VAL = 128
D_WIDTH = D_HEADS * D_VAL
FFN_HIDDEN = -(-8 * D_MODEL // (3 * 256)) * 256
ALPHA = (2 * DEPTH) ** 0.25
BETA = (8 * DEPTH) ** -0.25
LN_EPS = 1e-5
RMS_EPS = 1e-6
NEG = -1e30

AB_SPLITS = (A_HEADS * HEAD_DIM, A_KV_HEADS * HEAD_DIM, A_KV_HEADS * HEAD_DIM, B_WIDTH, B_WIDTH, B_WIDTH)
AB_IN = sum(AB_SPLITS)
AB_OUT = A_HEADS * HEAD_DIM + B_WIDTH
CD_SPLITS = (C_WIDTH, C_WIDTH, D_HEADS * D_KEY, D_HEADS * D_KEY, D_WIDTH, D_WIDTH)
CD_IN = sum(CD_SPLITS)
CD_OUT = C_WIDTH + D_WIDTH

kernel_name = 'hybrid_stream_encoder_step'


def split_cols(y, sizes):
    idx = [int(s) for s in np.cumsum(sizes)[:-1]]
    return jnp.split(y, idx, axis=-1)


def layer_norm(x, g, b):
    xf = x.astype(jnp.float32)
    mu = xf.mean(-1, keepdims=True)
    var = jnp.mean(jnp.square(xf - mu), -1, keepdims=True)
    return ((xf - mu) * lax.rsqrt(var + LN_EPS) * g + b).astype(x.dtype)


def ffn(h, w_gu, w_down):
    gate, up = jnp.split(h @ w_gu, 2, axis=-1)
    return (jax.nn.silu(gate) * up) @ w_down


def residual_block(h, mix, g1, b1, g2, b2, w_gu, w_down):
    h = layer_norm(ALPHA * h + mix, g1, b1)
    return layer_norm(ALPHA * h + ffn(h, w_gu, w_down), g2, b2)


def causal_dwconv(u, hist, w):
    width, ch = w.shape
    full = jnp.concatenate([hist.astype(u.dtype), u], axis=1)
    y = lax.conv_general_dilated(full, w.astype(u.dtype)[:, None, :], (1,), 'VALID',
                                 dimension_numbers=('NWC', 'WIO', 'NWC'), feature_group_count=ch)
    return y, full[:, full.shape[1] - (width - 1):]


def alibi_slopes(n):
    return jnp.asarray(np.exp2(-8.0 * np.arange(1, n + 1, dtype=np.float32) / n), jnp.float32)


def sink_attention(q, k, v, qpos, kpos, kvalid, sinks):
    bn, nblk, nq, nh, hd = q.shape
    nkv = k.shape[3]
    grp = nh // nkv
    qg = q.reshape(bn, nblk, nq, nkv, grp, hd)
    s = jnp.einsum('bnqkgd,bnskd->bnkgqs', qg, k, preferred_element_type=jnp.float32) * (hd ** -0.5)
    dist = jnp.abs(qpos[:, :, None] - kpos[:, None, :]).astype(jnp.float32)
    slopes = alibi_slopes(nh).reshape(nkv, grp)
    s = s - slopes[None, None, :, :, None, None] * dist[None, :, None, None]
    s = jnp.where(kvalid[None, :, None, None, None, :], s, NEG)
    sink = sinks.astype(jnp.float32).reshape(nkv, grp)[None, None, :, :, None, None]
    m = jnp.maximum(s.max(-1, keepdims=True), sink)
    p = jnp.exp(s - m)
    p = (p / (p.sum(-1, keepdims=True) + jnp.exp(sink - m))).astype(v.dtype)
    o = jnp.einsum('bnkgqs,bnskd->bnqkgd', p, v)
    return o.reshape(bn, nblk, nq, nh * hd)


def window_attention_prompt(q, k, v, sinks):
    bn, length = q.shape[:2]
    lp = length + PADF
    nb = lp // CHUNK
    front = lambda a, n: jnp.pad(a, ((0, 0), (n, 0), (0, 0), (0, 0)))
    qb = front(q, PADF).reshape(bn, nb, CHUNK, A_HEADS, HEAD_DIM)
    kp = front(k, PADF + WIN_CHUNKS * CHUNK).reshape(bn, nb + WIN_CHUNKS, CHUNK, A_KV_HEADS, HEAD_DIM)
    vp = front(v, PADF + WIN_CHUNKS * CHUNK).reshape(bn, nb + WIN_CHUNKS, CHUNK, A_KV_HEADS, HEAD_DIM)
    kband = jnp.concatenate([kp[:, j:j + nb] for j in range(WIN_CHUNKS + 1)], axis=2)
    vband = jnp.concatenate([vp[:, j:j + nb] for j in range(WIN_CHUNKS + 1)], axis=2)
    blk = jnp.arange(nb)[:, None]
    qpos = blk * CHUNK + jnp.arange(CHUNK)[None] - PADF
    kpos = (blk - WIN_CHUNKS) * CHUNK + jnp.arange((WIN_CHUNKS + 1) * CHUNK)[None] - PADF
    o = sink_attention(qb, kband, vband, qpos, kpos, kpos >= 0, sinks)
    return o.reshape(bn, lp, A_HEADS * HEAD_DIM)[:, PADF:]


def window_attention_sample(q, k_new, v_new, cache_k, cache_v, sinks):
    bn, t = q.shape[:2]
    w = cache_k.shape[1]
    kall = jnp.concatenate([cache_k.astype(k_new.dtype), k_new], axis=1)
    vall = jnp.concatenate([cache_v.astype(v_new.dtype), v_new], axis=1)
    qpos = (w + jnp.arange(t))[None]
    kpos = jnp.arange(w + t)[None]
    o = sink_attention(q[:, None], kall[:, None], vall[:, None], qpos, kpos, jnp.ones(kpos.shape, bool), sinks)
    return o.reshape(bn, t, A_HEADS * HEAD_DIM), kall[:, -w:], vall[:, -w:]


def ab_project(x, w_in, b_in):
    q, k, v, bg, cg, hb = split_cols(x @ w_in + b_in, AB_SPLITS)
    bn, t = x.shape[:2]
    q = q.reshape(bn, t, A_HEADS, HEAD_DIM)
    k = k.reshape(bn, t, A_KV_HEADS, HEAD_DIM)
    v = v.reshape(bn, t, A_KV_HEADS, HEAD_DIM)
    return q, k, v, bg, cg * hb


def mixer_ab_prompt(x, w_in, b_in, sinks, conv_w, w_o, win):
    q, k, v, bg, u = ab_project(x, w_in, b_in)
    attn = window_attention_prompt(q, k, v, sinks)
    cb, conv_state = causal_dwconv(u, jnp.zeros((x.shape[0], B_CONV - 1, B_WIDTH), x.dtype), conv_w)
    out = jnp.concatenate([attn, bg * cb], axis=-1) @ w_o
    return out, k[:, -win:], v[:, -win:], conv_state


def mixer_ab_sample(x, cache_k, cache_v, conv_hist, w_in, b_in, sinks, conv_w, w_o):
    q, k, v, bg, u = ab_project(x, w_in, b_in)
    attn, new_k, new_v = window_attention_sample(q, k, v, cache_k, cache_v, sinks)
    cb, conv_state = causal_dwconv(u, conv_hist, conv_w)
    out = jnp.concatenate([attn, bg * cb], axis=-1) @ w_o
    return out, new_k, new_v, conv_state


def hgrn_lower_bound(lower_bounds, layer):
    p = jax.nn.softmax(lower_bounds.astype(jnp.float32), axis=0)
    return (jnp.cumsum(p, axis=0) - p[0])[layer]


def cd_project(x, w_in, b_in, lb):
    a, gc, q, f, i, g = split_cols(x @ w_in + b_in, CD_SPLITS)
    bn, t = x.shape[:2]
    lbk = lb.reshape(D_HEADS, D_KEY)
    forget = lbk + (1.0 - lbk) * jax.nn.sigmoid(f.reshape(bn, t, D_HEADS, D_KEY).astype(jnp.float32))
    q = q.reshape(bn, t, D_HEADS, D_KEY).astype(jnp.float32)
    v = i.reshape(bn, t, D_HEADS, D_VAL).astype(jnp.float32)
    return a * jax.nn.sigmoid(gc), q, 1.0 - forget, v, jnp.log(forget), g


def conformer_conv(u, hist, conv_w, conv_b, ln_g, ln_b):
    c, new_hist = causal_dwconv(u, hist, conv_w)
    return jax.nn.silu(layer_norm(c + conv_b, ln_g, ln_b)), new_hist


def hgrn_block(S, qb, kb, vb, lfb):
    t = qb.shape[1]
    cum = jnp.cumsum(lfb, axis=1)
    o_inter = jnp.einsum('bthk,bhkv->bthv', qb * jnp.exp(cum), S)
    tri = jnp.tril(jnp.ones((t, t), bool))
    diff = cum[:, :, None] - cum[:, None, :]
    decay = jnp.exp(jnp.where(tri[None, :, :, None, None], diff, -jnp.inf))
    att = jnp.einsum('bthk,bshk,btshk->bhts', qb, kb, decay)
    o_intra = jnp.einsum('bhts,bshv->bthv', att, vb)
    tot = cum[:, -1]
    k_dec = kb * jnp.exp(tot[:, None] - cum)
    S_new = jnp.exp(tot)[..., None] * S + jnp.einsum('bshk,bshv->bhkv', k_dec, vb)
    return S_new, o_inter + o_intra


def hgrn_prompt(q, k, v, lf):
    bn = q.shape[0]
    pad = ((0, 0), (PADF, 0), (0, 0), (0, 0))
    q, k, v, lf = [jnp.pad(a, pad) for a in (q, k, v, lf)]
    nb = q.shape[1] // CHUNK
    blocks = lambda a: a.reshape(bn, nb, CHUNK, *a.shape[2:]).swapaxes(0, 1)
    S0 = jnp.zeros((bn, D_HEADS, D_KEY, D_VAL), jnp.float32)
    S, o = lax.scan(lambda s, xs: hgrn_block(s, *xs), S0, (blocks(q), blocks(k), blocks(v), blocks(lf)))
    o = o.swapaxes(0, 1).reshape(bn, nb * CHUNK, D_HEADS, D_VAL)[:, PADF:]
    return S, o


def hgrn_readout(o, g, norm_g):
    bn, t = o.shape[:2]
    o = o * lax.rsqrt(jnp.mean(o * o, -1, keepdims=True) + RMS_EPS)
    return (o.reshape(bn, t, D_WIDTH) * norm_g * jax.nn.silu(g.astype(jnp.float32))).astype(g.dtype)


def mixer_cd_prompt(x, w_in, b_in, conv_w, conv_b, ln_g, ln_b, lb, norm_g, w_o):
    u, q, k, v, lf, g = cd_project(x, w_in, b_in, lb)
    yc, conv_state = conformer_conv(u, jnp.zeros((x.shape[0], C_CONV - 1, C_WIDTH), x.dtype), conv_w, conv_b, ln_g, ln_b)
    S, o = hgrn_prompt(q, k, v, lf)
    out = jnp.concatenate([yc, hgrn_readout(o, g, norm_g)], axis=-1) @ w_o
    return out, conv_state, S.astype(x.dtype)


def mixer_cd_sample(x, conv_hist, S, w_in, b_in, conv_w, conv_b, ln_g, ln_b, lb, norm_g, w_o):
    u, q, k, v, lf, g = cd_project(x, w_in, b_in, lb)
    yc, conv_state = conformer_conv(u, conv_hist, conv_w, conv_b, ln_g, ln_b)
    S_new, o = hgrn_block(S.astype(jnp.float32), q, k, v, lf)
    out = jnp.concatenate([yc, hgrn_readout(o, g, norm_g)], axis=-1) @ w_o
    return out, conv_state, S_new.astype(x.dtype)


def setup_inputs(seed: int = 0) -> dict:
    key = jax.random.key(seed)
    ks = jax.random.split(key, 28)
    nrm = lambda k, shape, scale: scale * jax.random.normal(k, shape, jnp.float32)
    win = min(WINDOW, PAST_LEN)
    return {
        'x_prompt': nrm(ks[0], (BATCH, SEQ, D_MODEL), 1.0),
        'x_sample': nrm(ks[1], (DEC_BATCH, DEC_SEQ, D_MODEL), 1.0),
        'cache_k_a': nrm(ks[2], (DEC_BATCH, win, A_KV_HEADS, HEAD_DIM), 1.0),
        'cache_v_a': nrm(ks[3], (DEC_BATCH, win, A_KV_HEADS, HEAD_DIM), 1.0),
        'state_conv_b': nrm(ks[4], (DEC_BATCH, B_CONV - 1, B_WIDTH), 1.0),
        'state_conv_c': nrm(ks[5], (DEC_BATCH, C_CONV - 1, C_WIDTH), 0.5),
        'state_hgrn': nrm(ks[6], (DEC_BATCH, D_HEADS, D_KEY, D_VAL), 0.5),
        'meta_tokens': nrm(ks[7], (N_META, D_MODEL), 1.0),
        'ab_w_in': nrm(ks[8], (D_MODEL, AB_IN), D_MODEL ** -0.5),
        'ab_b_in': nrm(ks[9], (AB_IN,), 0.01),
        'a_sinks': nrm(ks[10], (A_HEADS,), 0.5),
        'b_conv_w': nrm(ks[11], (B_CONV, B_WIDTH), B_CONV ** -0.5),
        'ab_w_o': nrm(ks[12], (AB_OUT, D_MODEL), BETA * AB_OUT ** -0.5),
        'cd_w_in': nrm(ks[13], (D_MODEL, CD_IN), D_MODEL ** -0.5),
        'cd_b_in': nrm(ks[14], (CD_IN,), 0.01),
        'c_conv_w': nrm(ks[15], (C_CONV, C_WIDTH), C_CONV ** -0.5),
        'c_conv_b': nrm(ks[16], (C_WIDTH,), 0.01),
        'c_ln_g': 1.0 + nrm(ks[17], (C_WIDTH,), 0.01),
        'c_ln_b': nrm(ks[18], (C_WIDTH,), 0.01),
        'd_lower_bounds': nrm(ks[19], (DEPTH, D_HEADS * D_KEY), 0.1),
        'd_norm_g': 1.0 + nrm(ks[20], (D_WIDTH,), 0.01),
        'cd_w_o': nrm(ks[21], (CD_OUT, D_MODEL), BETA * CD_OUT ** -0.5),
        'ln1_g': 1.0 + nrm(ks[22], (DEPTH, D_MODEL), 0.01),
        'ln1_b': nrm(ks[23], (DEPTH, D_MODEL), 0.01),
        'ln2_g': 1.0 + nrm(ks[24], (DEPTH, D_MODEL), 0.01),
        'ln2_b': nrm(ks[25], (DEPTH, D_MODEL), 0.01),
        'ffn_w_gu': nrm(ks[26], (DEPTH, D_MODEL, 2 * FFN_HIDDEN), D_MODEL ** -0.5),
        'ffn_w_down': nrm(ks[27], (DEPTH, FFN_HIDDEN, D_MODEL), BETA * FFN_HIDDEN ** -0.5),
    }


def reference(x_prompt, x_sample, cache_k_a, cache_v_a, state_conv_b, state_conv_c, state_hgrn,
              meta_tokens, ab_w_in, ab_b_in, a_sinks, b_conv_w, ab_w_o, cd_w_in, cd_b_in,
              c_conv_w, c_conv_b, c_ln_g, c_ln_b, d_lower_bounds, d_norm_g, cd_w_o,
              ln1_g, ln1_b, ln2_g, ln2_b, ffn_w_gu, ffn_w_down):
    win = cache_k_a.shape[1]
    bp = x_prompt.shape[0]
    meta = jnp.broadcast_to(meta_tokens.astype(x_prompt.dtype)[None], (bp, N_META, D_MODEL))
    hp = jnp.concatenate([meta, x_prompt], axis=1)
    hs = x_sample
    for l in range(DEPTH):
        if l % 2 == 0:
            mp, k_a_p, v_a_p, conv_b_p = mixer_ab_prompt(hp, ab_w_in, ab_b_in, a_sinks, b_conv_w, ab_w_o, win)
            ms, k_a_s, v_a_s, conv_b_s = mixer_ab_sample(hs, cache_k_a, cache_v_a, state_conv_b,
                                                         ab_w_in, ab_b_in, a_sinks, b_conv_w, ab_w_o)
        else:
            lb = hgrn_lower_bound(d_lower_bounds, l)
            mp, conv_c_p, hgrn_p = mixer_cd_prompt(hp, cd_w_in, cd_b_in, c_conv_w, c_conv_b, c_ln_g, c_ln_b,
                                                   lb, d_norm_g, cd_w_o)
            ms, conv_c_s, hgrn_s = mixer_cd_sample(hs, state_conv_c, state_hgrn, cd_w_in, cd_b_in, c_conv_w,
                                                   c_conv_b, c_ln_g, c_ln_b, lb, d_norm_g, cd_w_o)
        hp = residual_block(hp, mp, ln1_g[l], ln1_b[l], ln2_g[l], ln2_b[l], ffn_w_gu[l], ffn_w_down[l])
        hs = residual_block(hs, ms, ln1_g[l], ln1_b[l], ln2_g[l], ln2_b[l], ffn_w_gu[l], ffn_w_down[l])
    y_prompt = hp[:, N_META:]
    return (y_prompt, hs, k_a_p, v_a_p, conv_b_p, conv_c_p, hgrn_p, k_a_s, v_a_s, conv_b_s, conv_c_s, hgrn_s)
```

```cpp
#include <hip/hip_runtime.h>
#include <cstdint>
#include <cstdio>

typedef unsigned short bf16_t;
typedef short bf16x8 __attribute__((ext_vector_type(8)));
typedef float f32x4 __attribute__((ext_vector_type(4)));

constexpr int D = 1024;
constexpr int NB = 4, SEQ = 4096, NMETA = 16, TP = SEQ + NMETA  , PADF = 48, TPP = TP + PADF  ;
constexpr int NS = 8, TS = 64;
constexpr int MP_PROMPT = NB * TPP;
constexpr int MP = MP_PROMPT + NS * TS;
constexpr int NTILE64 = MP / 64;
constexpr int AB_IN = 2304, CD_IN = 3072, FH = 2816;
constexpr float ALPHA = 1.4142135623730951f;

constexpr size_t O_YP = 0, O_YS = 16777216, O_KAP = 17301504, O_VAP = 17367040, O_CBP = 17432576, O_CCP = 17436672,
                 O_HGP = 17498112, O_KAS = 17760256, O_VAS = 17891328, O_CBS = 18022400, O_CCS = 18030592, O_HGS = 18153472;

__device__ __forceinline__ bf16_t f2bf(float f) { unsigned u = __float_as_uint(f); u += 0x7fffu + ((u >> 16) & 1u); return (bf16_t)(u >> 16); }
__device__ __forceinline__ float bf2f(bf16_t h) { return __uint_as_float(((unsigned)h) << 16); }
__device__ __forceinline__ float sigmoidf_(float x) { return 1.0f / (1.0f + __expf(-x)); }
__device__ __forceinline__ float siluf_(float x) { return x / (1.0f + __expf(-x)); }

__global__ __launch_bounds__(256) void transpose_w(const float* __restrict__ W, bf16_t* __restrict__ Wt, int K, int N) {
    __shared__ float t[32][33];
    const int n0 = blockIdx.x * 32, k0 = blockIdx.y * 32, tx = threadIdx.x & 31, ty = threadIdx.x >> 5;
    for (int i = ty; i < 32; i += 8) t[i][tx] = W[(size_t)(k0 + i) * N + n0 + tx];
    __syncthreads();
    for (int i = ty; i < 32; i += 8) Wt[(size_t)(n0 + i) * K + k0 + tx] = f2bf(t[tx][i]);
}

__global__ __launch_bounds__(256) void embed(const float* __restrict__ xp, const float* __restrict__ xs, const float* __restrict__ meta, bf16_t* __restrict__ Hb) {
    const int row = blockIdx.x; const float* src = nullptr;
    if (row < MP_PROMPT) { const int b = row / TPP, p = row % TPP; if (p >= PADF) { const int i = p - PADF; src = i < NMETA ? meta + (size_t)i * D : xp + ((size_t)b * SEQ + (i - NMETA)) * D; } }
    else src = xs + (size_t)(row - MP_PROMPT) * D;
    for (int c = threadIdx.x; c < D; c += 256) Hb[(size_t)row * D + c] = src ? f2bf(src[c]) : (bf16_t)0;
}

__global__ void lb_kernel(const float* __restrict__ dlb, float* __restrict__ lb) {
    const int c = blockIdx.x * blockDim.x + threadIdx.x; if (c < 512) { const float l0 = dlb[c], l1 = dlb[512 + c]; const float m = fmaxf(l0, l1); const float e0 = expf(l0 - m), e1 = expf(l1 - m); lb[c] = e1 / (e0 + e1); }
}

template <int EPI>
__global__ __launch_bounds__(256) void gemm_v1(const bf16_t* __restrict__ A, const bf16_t* __restrict__ Bt, const bf16_t* __restrict__ Bt2, int K, void* __restrict__ out, int ldc, const float* __restrict__ bias) {
    __shared__ __attribute__((aligned(16))) bf16_t As[128 * 40];
    __shared__ __attribute__((aligned(16))) bf16_t Bs[128 * 40];
    __shared__ __attribute__((aligned(16))) bf16_t Bs2[EPI == 2 ? 128 * 40 : 8];
    const int tid = threadIdx.x, lane = tid & 63, wid = tid >> 6, wr = wid >> 1, wc = wid & 1, fr = lane & 15, fq = lane >> 4;
    const int m0 = blockIdx.y * 128, n0 = blockIdx.x * 128;
    f32x4 acc[4][4], acc2[4][4];
#pragma unroll
    for (int m = 0; m < 4; ++m)
#pragma unroll
        for (int n = 0; n < 4; ++n) { acc[m][n] = (f32x4){0.f, 0.f, 0.f, 0.f}; acc2[m][n] = (f32x4){0.f, 0.f, 0.f, 0.f}; }
    const int sr = tid >> 1, sc = (tid & 1) * 16;
    const bf16_t* ap = A + (size_t)(m0 + sr) * K + sc;
    const bf16_t* bp = Bt + (size_t)(n0 + sr) * K + sc;
    const bf16_t* bp2 = EPI == 2 ? Bt2 + (size_t)(n0 + sr) * K + sc : nullptr;
    for (int k0 = 0; k0 < K; k0 += 32) {
        const uint4 a0 = *(const uint4*)(ap + k0), a1 = *(const uint4*)(ap + k0 + 8);
        const uint4 b0 = *(const uint4*)(bp + k0), b1 = *(const uint4*)(bp + k0 + 8);
        uint4 c0 = {0, 0, 0, 0}, c1 = {0, 0, 0, 0};
        if (EPI == 2) { c0 = *(const uint4*)(bp2 + k0); c1 = *(const uint4*)(bp2 + k0 + 8); }
        __syncthreads();
        *(uint4*)(As + sr * 40 + sc) = a0; *(uint4*)(As + sr * 40 + sc + 8) = a1;
        *(uint4*)(Bs + sr * 40 + sc) = b0; *(uint4*)(Bs + sr * 40 + sc + 8) = b1;
        if (EPI == 2) { *(uint4*)(Bs2 + sr * 40 + sc) = c0; *(uint4*)(Bs2 + sr * 40 + sc + 8) = c1; }
        __syncthreads();
        bf16x8 a[4], b[4];
#pragma unroll
        for (int m = 0; m < 4; ++m) a[m] = *(const bf16x8*)(As + (wr * 64 + m * 16 + fr) * 40 + fq * 8);
#pragma unroll
        for (int n = 0; n < 4; ++n) b[n] = *(const bf16x8*)(Bs + (wc * 64 + n * 16 + fr) * 40 + fq * 8);
#pragma unroll
        for (int m = 0; m < 4; ++m)
#pragma unroll
            for (int n = 0; n < 4; ++n) acc[m][n] = __builtin_amdgcn_mfma_f32_16x16x32_bf16(b[n], a[m], acc[m][n], 0, 0, 0);
        if (EPI == 2) {
#pragma unroll
            for (int n = 0; n < 4; ++n) b[n] = *(const bf16x8*)(Bs2 + (wc * 64 + n * 16 + fr) * 40 + fq * 8);
#pragma unroll
            for (int m = 0; m < 4; ++m)
#pragma unroll
                for (int n = 0; n < 4; ++n) acc2[m][n] = __builtin_amdgcn_mfma_f32_16x16x32_bf16(b[n], a[m], acc2[m][n], 0, 0, 0);
        }
    }
#pragma unroll
    for (int m = 0; m < 4; ++m)
#pragma unroll
        for (int n = 0; n < 4; ++n) {
            const int row = m0 + wr * 64 + m * 16 + fr, col = n0 + wc * 64 + n * 16 + 4 * fq;
            if (EPI == 0) { bf16_t* o = (bf16_t*)out + (size_t)row * ldc + col;
#pragma unroll
                for (int r = 0; r < 4; ++r) o[r] = f2bf(acc[m][n][r] + (bias ? bias[col + r] : 0.f)); }
            else if (EPI == 1) { float* o = (float*)out + (size_t)row * ldc + col; *(f32x4*)o = acc[m][n]; }
            else { bf16_t* o = (bf16_t*)out + (size_t)row * ldc + col;
#pragma unroll
                for (int r = 0; r < 4; ++r) o[r] = f2bf(siluf_(acc[m][n][r]) * acc2[m][n][r]); }
        }
}

__global__ __launch_bounds__(256) void ln_residual(bf16_t* __restrict__ Hb, const float* __restrict__ mix, int row0, const float* __restrict__ g, const float* __restrict__ b, float* __restrict__ outf  ) {
    const int r = blockIdx.x, row = row0 + r, tid = threadIdx.x;
    __shared__ float red[8];
    float y[4]; float s = 0.f;
#pragma unroll
    for (int i = 0; i < 4; ++i) { const int c = tid + i * 256; y[i] = ALPHA * bf2f(Hb[(size_t)row * D + c]) + mix[(size_t)r * D + c]; s += y[i]; }
    for (int o = 32; o > 0; o >>= 1) s += __shfl_xor(s, o);
    if ((tid & 63) == 0) red[tid >> 6] = s;
    __syncthreads();
    const float mu = (red[0] + red[1] + red[2] + red[3]) * (1.0f / D);
    float q = 0.f;
#pragma unroll
    for (int i = 0; i < 4; ++i) { const float d = y[i] - mu; q += d * d; }
    for (int o = 32; o > 0; o >>= 1) q += __shfl_xor(q, o);
    if ((tid & 63) == 0) red[4 + (tid >> 6)] = q;
    __syncthreads();
    const float rstd = rsqrtf((red[4] + red[5] + red[6] + red[7]) * (1.0f / D) + 1e-5f);
    float* op = nullptr;
    if (outf) { if (row < MP_PROMPT) { const int bb = row / TPP, p = row % TPP; if (p >= PADF + NMETA) op = outf + O_YP + ((size_t)bb * SEQ + (p - PADF - NMETA)) * D; } else op = outf + O_YS + (size_t)(row - MP_PROMPT) * D; }
#pragma unroll
    for (int i = 0; i < 4; ++i) { const int c = tid + i * 256; const float v = (y[i] - mu) * rstd * g[c] + b[c]; Hb[(size_t)row * D + c] = f2bf(v); if (op) op[c] = v; }
}

__global__ __launch_bounds__(256) void attn_v1(const bf16_t* __restrict__ P0, const float* __restrict__ ck, const float* __restrict__ cv, const float* __restrict__ sinks, bf16_t* __restrict__ MIX) {
    __shared__ __attribute__((aligned(16))) bf16_t Ks[192 * 64];
    __shared__ __attribute__((aligned(16))) bf16_t Vs[192 * 64];
    const int T = blockIdx.x, kvh = blockIdx.y, tid = threadIdx.x;
    const bool samp = T >= NB * 65; const int s = T - NB * 65, c = samp ? 0 : T % 65;
    const int row0 = T * 64;
    for (int idx = tid; idx < 192 * 64; idx += 256) {
        const int j = idx >> 6, d = idx & 63; bf16_t kv = 0, vv = 0;
        if (samp) { if (j < 128) { kv = f2bf(ck[(((size_t)s * 128 + j) * 2 + kvh) * 64 + d]); vv = f2bf(cv[(((size_t)s * 128 + j) * 2 + kvh) * 64 + d]); }
                    else { const size_t r = (size_t)(row0 + j - 128) * AB_IN; kv = P0[r + 512 + kvh * 64 + d]; vv = P0[r + 640 + kvh * 64 + d]; } }
        else { const int rel = (c - 2) * 64 + j; if (rel >= PADF) { const size_t r = (size_t)(row0 - 128 + j) * AB_IN; kv = P0[r + 512 + kvh * 64 + d]; vv = P0[r + 640 + kvh * 64 + d]; } }
        Ks[idx] = kv; Vs[idx] = vv;
    }
    __syncthreads();
    const int t = tid >> 2, g = tid & 3, h = kvh * 4 + g;
    const float slope = exp2f(-(float)(h + 1)), sink = sinks[h];
    float q[64], o[64];
    { const bf16_t* qp = P0 + (size_t)(row0 + t) * AB_IN + h * 64;
#pragma unroll
      for (int d = 0; d < 64; ++d) { q[d] = bf2f(qp[d]) * 0.125f; o[d] = 0.f; } }
    float m = sink, l = 1.0f;
    const int jmin = samp ? 0 : ((c - 2) * 64 >= PADF ? 0 : PADF - (c - 2) * 64);
    for (int j = jmin; j < 192; ++j) {
        float sc = 0.f;
#pragma unroll
        for (int d = 0; d < 64; ++d) sc += q[d] * bf2f(Ks[j * 64 + d]);
        sc -= slope * fabsf((float)(128 + t - j));
        const float mn = fmaxf(m, sc), a = __expf(m - mn), p = __expf(sc - mn);
        l = l * a + p; m = mn;
#pragma unroll
        for (int d = 0; d < 64; ++d) o[d] = o[d] * a + p * bf2f(Vs[j * 64 + d]);
    }
    const float inv = 1.0f / l;
    bf16_t* op = MIX + (size_t)(row0 + t) * D + h * 64;
#pragma unroll
    for (int d = 0; d < 64; ++d) op[d] = f2bf(o[d] * inv);
}

__device__ __forceinline__ float convb_u(const bf16_t* __restrict__ P0, const float* __restrict__ stb, int row, int back, int ch) {
    if (row < MP_PROMPT) { const int p = row % TPP - back; if (p < PADF) return 0.f; const size_t r = (size_t)(row - back) * AB_IN; return bf2f(P0[r + 1280 + ch]) * bf2f(P0[r + 1792 + ch]); }
    const int s = (row - MP_PROMPT) / TS, t = (row - MP_PROMPT) % TS - back;
    if (t < 0) return stb[((size_t)s * 2 + (2 + t)) * 512 + ch];
    const size_t r = (size_t)(row - back) * AB_IN; return bf2f(P0[r + 1280 + ch]) * bf2f(P0[r + 1792 + ch]);
}
__global__ __launch_bounds__(256) void convb_v1(const bf16_t* __restrict__ P0, const float* __restrict__ stb, const float* __restrict__ w, bf16_t* __restrict__ MIX) {
    const int row = blockIdx.x;
    for (int ch = threadIdx.x; ch < 512; ch += 256) {
        const float cb = w[ch] * convb_u(P0, stb, row, 2, ch) + w[512 + ch] * convb_u(P0, stb, row, 1, ch) + w[1024 + ch] * convb_u(P0, stb, row, 0, ch);
        MIX[(size_t)row * D + 512 + ch] = f2bf(bf2f(P0[(size_t)row * AB_IN + 768 + ch]) * cb);
    }
}

__global__ __launch_bounds__(256) void outs_l0(const bf16_t* __restrict__ P0, const float* __restrict__ ck, const float* __restrict__ cv, float* __restrict__ out) {
    const int gid = blockIdx.x * 256 + threadIdx.x;
    if (gid < 65536) {
        const int b = gid >> 14, j = (gid >> 7) & 127, cc = gid & 127; const size_t r = (size_t)(b * TPP + PADF + TP - 128 + j) * AB_IN;
        out[O_KAP + gid] = bf2f(P0[r + 512 + cc]); out[O_VAP + gid] = bf2f(P0[r + 640 + cc]);
    }
    if (gid < 131072) {
        const int s = gid >> 14, j = (gid >> 7) & 127, cc = gid & 127;
        if (j < 64) { out[O_KAS + gid] = ck[((size_t)s * 128 + 64 + j) * 128 + cc]; out[O_VAS + gid] = cv[((size_t)s * 128 + 64 + j) * 128 + cc]; }
        else { const size_t r = (size_t)(MP_PROMPT + s * 64 + (j - 64)) * AB_IN; out[O_KAS + gid] = bf2f(P0[r + 512 + cc]); out[O_VAS + gid] = bf2f(P0[r + 640 + cc]); }
    }
    if (gid < 4096) {
        const int b = gid >> 10, j = (gid >> 9) & 1, ch = gid & 511; const size_t r = (size_t)(b * TPP + PADF + TP - 2 + j) * AB_IN;
        out[O_CBP + gid] = bf2f(P0[r + 1280 + ch]) * bf2f(P0[r + 1792 + ch]);
    }
    if (gid < 8192) {
        const int s = gid >> 10, j = (gid >> 9) & 1, ch = gid & 511; const size_t r = (size_t)(MP_PROMPT + s * 64 + 62 + j) * AB_IN;
        out[O_CBS + gid] = bf2f(P0[r + 1280 + ch]) * bf2f(P0[r + 1792 + ch]);
    }
}

__device__ __forceinline__ float convc_u(const bf16_t* __restrict__ P1, const float* __restrict__ stc, int row, int back, int ch) {
    if (row < MP_PROMPT) { const int p = row % TPP - back; if (p < PADF) return 0.f; const size_t r = (size_t)(row - back) * CD_IN; return bf2f(P1[r + ch]) * sigmoidf_(bf2f(P1[r + 512 + ch])); }
    const int s = (row - MP_PROMPT) / TS, t = (row - MP_PROMPT) % TS - back;
    if (t < 0) return stc[((size_t)s * 30 + (30 + t)) * 512 + ch];
    const size_t r = (size_t)(row - back) * CD_IN; return bf2f(P1[r + ch]) * sigmoidf_(bf2f(P1[r + 512 + ch]));
}
__global__ __launch_bounds__(256) void convc_v1(const bf16_t* __restrict__ P1, const float* __restrict__ stc, const float* __restrict__ w, const float* __restrict__ cb, const float* __restrict__ lg, const float* __restrict__ lbv, bf16_t* __restrict__ MIX) {
    const int row = blockIdx.x, tid = threadIdx.x;
    __shared__ float red[8];
    float c[2];
#pragma unroll
    for (int i = 0; i < 2; ++i) { const int ch = tid + i * 256; float a = cb[ch];
        for (int j = 0; j < 31; ++j) a += w[j * 512 + ch] * convc_u(P1, stc, row, 30 - j, ch);
        c[i] = a; }
    float s = c[0] + c[1];
    for (int o = 32; o > 0; o >>= 1) s += __shfl_xor(s, o);
    if ((tid & 63) == 0) red[tid >> 6] = s;
    __syncthreads();
    const float mu = (red[0] + red[1] + red[2] + red[3]) * (1.0f / 512.0f);
    float q = (c[0] - mu) * (c[0] - mu) + (c[1] - mu) * (c[1] - mu);
    for (int o = 32; o > 0; o >>= 1) q += __shfl_xor(q, o);
    if ((tid & 63) == 0) red[4 + (tid >> 6)] = q;
    __syncthreads();
    const float rstd = rsqrtf((red[4] + red[5] + red[6] + red[7]) * (1.0f / 512.0f) + 1e-5f);
#pragma unroll
    for (int i = 0; i < 2; ++i) { const int ch = tid + i * 256; MIX[(size_t)row * D + ch] = f2bf(siluf_((c[i] - mu) * rstd * lg[ch] + lbv[ch])); }
}
__global__ __launch_bounds__(256) void outs_l1(const bf16_t* __restrict__ P1, float* __restrict__ out) {
    const int gid = blockIdx.x * 256 + threadIdx.x;
    if (gid < 61440) { const int b = gid / 15360, j = (gid / 512) % 30, ch = gid & 511; const size_t r = (size_t)(b * TPP + PADF + TP - 30 + j) * CD_IN;
        out[O_CCP + gid] = bf2f(P1[r + ch]) * sigmoidf_(bf2f(P1[r + 512 + ch])); }
    if (gid < 122880) { const int s = gid / 15360, j = (gid / 512) % 30, ch = gid & 511; const size_t r = (size_t)(MP_PROMPT + s * 64 + 34 + j) * CD_IN;
        out[O_CCS + gid] = bf2f(P1[r + ch]) * sigmoidf_(bf2f(P1[r + 512 + ch])); }
}

__global__ __launch_bounds__(256) void hgrn_v1(const bf16_t* __restrict__ P1, const float* __restrict__ lb, const float* __restrict__ st_in, float* __restrict__ obuf, float* __restrict__ out) {
    __shared__ float sq[16][128], sf[16][128], sk[16][128], so[16][2][128];
    const int id = blockIdx.x, tid = threadIdx.x, v = tid & 127, kh = tid >> 7;
    const bool samp = id >= 16; const int seq = samp ? (id - 16) >> 2 : id >> 2, h = id & 3;
    const int row0 = samp ? MP_PROMPT + seq * 64 : seq * TPP + PADF, ntok = samp ? 64 : TP;
    float S[64];
#pragma unroll
    for (int kk = 0; kk < 64; ++kk) S[kk] = samp ? st_in[(((size_t)seq * 4 + h) * 128 + kh * 64 + kk) * 128 + v] : 0.f;
    for (int t0 = 0; t0 < ntok; t0 += 16) {
        { const int tt = tid >> 4, kb = (tid & 15) * 8; const size_t r = (size_t)(row0 + t0 + tt) * CD_IN;
#pragma unroll
          for (int i = 0; i < 8; ++i) { const int k = kb + i; const float lbv = lb[h * 128 + k]; const float fg = lbv + (1.0f - lbv) * sigmoidf_(bf2f(P1[r + 1536 + h * 128 + k]));
              sq[tt][k] = bf2f(P1[r + 1024 + h * 128 + k]); sf[tt][k] = fg; sk[tt][k] = 1.0f - fg; } }
        __syncthreads();
        for (int tt = 0; tt < 16; ++tt) {
            const float vt = bf2f(P1[(size_t)(row0 + t0 + tt) * CD_IN + 2048 + h * 128 + v]);
            float a = 0.f;
#pragma unroll
            for (int kk = 0; kk < 64; ++kk) { const int k = kh * 64 + kk; S[kk] = sf[tt][k] * S[kk] + sk[tt][k] * vt; a += S[kk] * sq[tt][k]; }
            so[tt][kh][v] = a;
        }
        __syncthreads();
        for (int idx = tid; idx < 16 * 128; idx += 256) { const int tt = idx >> 7, v2 = idx & 127; obuf[(size_t)(row0 + t0 + tt) * 512 + h * 128 + v2] = so[tt][0][v2] + so[tt][1][v2]; }
    }
    float* op = out + (samp ? O_HGS : O_HGP) + (((size_t)seq * 4 + h) * 128 + kh * 64) * 128 + v;
#pragma unroll
    for (int kk = 0; kk < 64; ++kk) op[(size_t)kk * 128] = S[kk];
}
__global__ __launch_bounds__(256) void readout_v1(const float* __restrict__ obuf, const bf16_t* __restrict__ P1, const float* __restrict__ ng, bf16_t* __restrict__ MIX) {
    const int row = blockIdx.x, tid = threadIdx.x;
    const int c0 = tid * 2; const float a = obuf[(size_t)row * 512 + c0], b = obuf[(size_t)row * 512 + c0 + 1];
    float q = a * a + b * b;
    for (int o = 32; o > 0; o >>= 1) q += __shfl_xor(q, o);
    const float r = rsqrtf(q * (1.0f / 128.0f) + 1e-6f);
    const float g0 = bf2f(P1[(size_t)row * CD_IN + 2560 + c0]), g1 = bf2f(P1[(size_t)row * CD_IN + 2560 + c0 + 1]);
    MIX[(size_t)row * D + 512 + c0] = f2bf(a * r * ng[c0] * siluf_(g0)); MIX[(size_t)row * D + 512 + c0 + 1] = f2bf(b * r * ng[c0 + 1] * siluf_(g1));
}

extern "C" void kernel_launch(void* const* d_in, const int* in_sizes, int n_in, void* d_out, int out_size, void* d_ws, size_t ws_size, hipStream_t stream) {
    const float* x_prompt = (const float*)d_in[0]; const float* x_sample = (const float*)d_in[1];
    const float* cache_k = (const float*)d_in[2]; const float* cache_v = (const float*)d_in[3];
    const float* st_convb = (const float*)d_in[4]; const float* st_convc = (const float*)d_in[5]; const float* st_hgrn = (const float*)d_in[6];
    const float* meta = (const float*)d_in[7]; const float* ab_w_in = (const float*)d_in[8]; const float* ab_b_in = (const float*)d_in[9];
    const float* a_sinks = (const float*)d_in[10]; const float* b_conv_w = (const float*)d_in[11]; const float* ab_w_o = (const float*)d_in[12];
    const float* cd_w_in = (const float*)d_in[13]; const float* cd_b_in = (const float*)d_in[14]; const float* c_conv_w = (const float*)d_in[15];
    const float* c_conv_b = (const float*)d_in[16]; const float* c_ln_g = (const float*)d_in[17]; const float* c_ln_b = (const float*)d_in[18];
    const float* d_lbs = (const float*)d_in[19]; const float* d_norm_g = (const float*)d_in[20]; const float* cd_w_o = (const float*)d_in[21];
    const float* ln1_g = (const float*)d_in[22]; const float* ln1_b = (const float*)d_in[23]; const float* ln2_g = (const float*)d_in[24]; const float* ln2_b = (const float*)d_in[25];
    const float* w_gu = (const float*)d_in[26]; const float* w_down = (const float*)d_in[27];
    float* out = (float*)d_out;
    char* ws = (char*)d_ws; size_t off = 0;
    auto take = [&](size_t bytes) { char* p = ws + off; off += (bytes + 255) & ~(size_t)255; return p; };
    bf16_t* Wab_in = (bf16_t*)take((size_t)AB_IN * D * 2); bf16_t* Wab_o = (bf16_t*)take((size_t)D * D * 2);
    bf16_t* Wcd_in = (bf16_t*)take((size_t)CD_IN * D * 2); bf16_t* Wcd_o = (bf16_t*)take((size_t)D * D * 2);
    bf16_t* Wgu = (bf16_t*)take((size_t)2 * 2 * FH * D * 2); bf16_t* Wdn = (bf16_t*)take((size_t)2 * D * FH * 2);
    bf16_t* Hb = (bf16_t*)take((size_t)MP * D * 2);
    bf16_t* P = (bf16_t*)take((size_t)MP * CD_IN * 2);
    bf16_t* MIX = (bf16_t*)take((size_t)MP * D * 2);
    float* SPARE = (float*)take((size_t)MP * 512 * 4);
    float* lb = (float*)take(512 * 4);
    if (off > ws_size) { fprintf(stderr, "workspace too small: need %zu have %zu\n", off, ws_size); return; }

    transpose_w<<<dim3(AB_IN / 32, D / 32), 256, 0, stream>>>(ab_w_in, Wab_in, D, AB_IN);
    transpose_w<<<dim3(D / 32, D / 32), 256, 0, stream>>>(ab_w_o, Wab_o, D, D);
    transpose_w<<<dim3(CD_IN / 32, D / 32), 256, 0, stream>>>(cd_w_in, Wcd_in, D, CD_IN);
    transpose_w<<<dim3(D / 32, D / 32), 256, 0, stream>>>(cd_w_o, Wcd_o, D, D);
    for (int l = 0; l < 2; ++l) {
        transpose_w<<<dim3(2 * FH / 32, D / 32), 256, 0, stream>>>(w_gu + (size_t)l * D * 2 * FH, Wgu + (size_t)l * 2 * FH * D, D, 2 * FH);
        transpose_w<<<dim3(D / 32, FH / 32), 256, 0, stream>>>(w_down + (size_t)l * FH * D, Wdn + (size_t)l * D * FH, FH, D);
    }
    lb_kernel<<<2, 256, 0, stream>>>(d_lbs, lb);
    embed<<<MP, 256, 0, stream>>>(x_prompt, x_sample, meta, Hb);

    for (int l = 0; l < 2; ++l) {
        if (l == 0) {
            gemm_v1<0><<<dim3(AB_IN / 128, MP / 128), 256, 0, stream>>>(Hb, Wab_in, nullptr, D, P, AB_IN, ab_b_in);
            attn_v1<<<dim3(NTILE64, 2), 256, 0, stream>>>(P, cache_k, cache_v, a_sinks, MIX);
            convb_v1<<<MP, 256, 0, stream>>>(P, st_convb, b_conv_w, MIX);
            outs_l0<<<512, 256, 0, stream>>>(P, cache_k, cache_v, out);
        } else {
            gemm_v1<0><<<dim3(CD_IN / 128, MP / 128), 256, 0, stream>>>(Hb, Wcd_in, nullptr, D, P, CD_IN, cd_b_in);
            convc_v1<<<MP, 256, 0, stream>>>(P, st_convc, c_conv_w, c_conv_b, c_ln_g, c_ln_b, MIX);
            outs_l1<<<480, 256, 0, stream>>>(P, out);
            hgrn_v1<<<48, 256, 0, stream>>>(P, lb, st_hgrn, SPARE, out);
            readout_v1<<<MP, 256, 0, stream>>>(SPARE, P, d_norm_g, MIX);
        }
        const bf16_t* Wo = l == 0 ? Wab_o : Wcd_o;
        for (int hf = 0; hf < 2; ++hf) {
            const int r0 = hf * (MP / 2);
            gemm_v1<1><<<dim3(D / 128, MP / 2 / 128), 256, 0, stream>>>(MIX + (size_t)r0 * D, Wo, nullptr, D, SPARE, D, nullptr);
            ln_residual<<<MP / 2, 256, 0, stream>>>(Hb, SPARE, r0, ln1_g + l * D, ln1_b + l * D, nullptr);
        }
        const bf16_t* Wg = Wgu + (size_t)l * 2 * FH * D;
        gemm_v1<2><<<dim3(FH / 128, MP / 128), 256, 0, stream>>>(Hb, Wg, Wg + (size_t)FH * D, D, P, FH, nullptr);
        for (int hf = 0; hf < 2; ++hf) {
            const int r0 = hf * (MP / 2);
            gemm_v1<1><<<dim3(D / 128, MP / 2 / 128), 256, 0, stream>>>(P + (size_t)r0 * FH, Wdn + (size_t)l * D * FH, nullptr, FH, SPARE, D, nullptr);
            ln_residual<<<MP / 2, 256, 0, stream>>>(Hb, SPARE, r0, ln2_g + l * D, ln2_b + l * D, l == 1 ? out : nullptr);
        }
    }
}
```

```cpp
#include <hip/hip_runtime.h>
#include <cstdint>
#include <cstdio>

#define LAS __attribute__((address_space(3)))
typedef unsigned short bf16_t;
typedef short bf16x8 __attribute__((ext_vector_type(8)));
typedef float f32x4 __attribute__((ext_vector_type(4)));
typedef unsigned v4u __attribute__((ext_vector_type(4)));
typedef unsigned v2u __attribute__((ext_vector_type(2)));

constexpr int D = 1024;
constexpr int NB = 4, SEQ = 4096, NMETA = 16, TP = SEQ + NMETA  , PADF = 48, TPP = TP + PADF  ;
constexpr int NS = 8, TS = 64;
constexpr int MP_PROMPT = NB * TPP;
constexpr int MP = MP_PROMPT + NS * TS;
constexpr int NTILE64 = MP / 64;
constexpr int AB_IN = 2304, CD_IN = 3072, FH = 2816;
constexpr float ALPHA = 1.4142135623730951f;
constexpr int NTHREADS = 512, NWAVES = 8;

constexpr size_t O_YP = 0, O_YS = 16777216, O_KAP = 17301504, O_VAP = 17367040, O_CBP = 17432576, O_CCP = 17436672,
                 O_HGP = 17498112, O_KAS = 17760256, O_VAS = 17891328, O_CBS = 18022400, O_CCS = 18030592, O_HGS = 18153472;

constexpr size_t WS_CTL = 0, CTL_ZERO_BYTES = 65536;
constexpr size_t WS_WAB_IN = 1u << 20;
constexpr size_t WS_WAB_O = WS_WAB_IN + (size_t)AB_IN * D * 2;
constexpr size_t WS_WCD_IN = WS_WAB_O + (size_t)D * D * 2;
constexpr size_t WS_WCD_O = WS_WCD_IN + (size_t)CD_IN * D * 2;
constexpr size_t WS_WGU = WS_WCD_O + (size_t)D * D * 2;
constexpr size_t WS_WDN = WS_WGU + (size_t)2 * 2 * FH * D * 2;
constexpr size_t WS_LB = WS_WDN + (size_t)2 * D * FH * 2;
constexpr size_t WS_HB = WS_LB + 4096;
constexpr size_t WS_P = WS_HB + (size_t)MP * D * 2;
constexpr size_t WS_MIX = WS_P + (size_t)MP * CD_IN * 2;
constexpr size_t WS_SPARE = WS_MIX + (size_t)MP * D * 2;
constexpr size_t WS_END = WS_SPARE + (size_t)MP * 512 * 4;
static_assert(WS_END <= 268435456, "workspace map");
constexpr int CW_BAR = 4096;

constexpr int LDS_SCRATCH = 131072, LDSCTL_OFF = LDS_SCRATCH, LDS_BYTES = 147456;

__device__ __forceinline__ bf16_t f2bf(float f) { unsigned u = __float_as_uint(f); u += 0x7fffu + ((u >> 16) & 1u); return (bf16_t)(u >> 16); }
__device__ __forceinline__ unsigned pk2(float lo, float hi) { return (unsigned)f2bf(lo) | ((unsigned)f2bf(hi) << 16); }
__device__ __forceinline__ float bf2f(bf16_t h) { return __uint_as_float(((unsigned)h) << 16); }
__device__ __forceinline__ float sigmoidf_(float x) { return 1.0f / (1.0f + __expf(-x)); }
__device__ __forceinline__ float siluf_(float x) { return x / (1.0f + __expf(-x)); }
__device__ __forceinline__ float wave_sum(float v) {
#pragma unroll
    for (int o = 1; o < 64; o <<= 1) v += __shfl_xor(v, o);
    return v;
}

#define XB_TMO      128
#define XB_XCNT(j)  (256  + 64 * (j))
#define XB_XSUB(j)  (1280 + 64 * (j))
#define XB_XGEN(j)  (2304 + 64 * (j))
#define XB_TOP      3328
#define XB_TOPGEN   3392
#define XCD_BAR_WORDS 3456
#define XB_SPIN_CAP (1u << 18)
__device__ __forceinline__ unsigned xb_ld(unsigned* p)              { return __hip_atomic_load(p, __ATOMIC_RELAXED, __HIP_MEMORY_SCOPE_AGENT); }
__device__ __forceinline__ unsigned xb_add(unsigned* p, unsigned v) { return __hip_atomic_fetch_add(p, v, __ATOMIC_RELAXED, __HIP_MEMORY_SCOPE_AGENT); }
__device__ __forceinline__ unsigned xb_xcc_id() { return (unsigned)__builtin_amdgcn_s_getreg((3 << 11) | 20) & 0xFu; }
#define XB_SPIN(cond, bar) do { unsigned _sp = 0; while (cond) { __builtin_amdgcn_s_sleep(1); \
    if ((++_sp & 255u) == 0u) { if (xb_ld(&(bar)[XB_TMO])) break; if (_sp > XB_SPIN_CAP) { atomicAdd(&(bar)[XB_TMO], 1u); break; } } } } while (0)
struct XcdBarrier { unsigned* bar; unsigned x; volatile LAS unsigned* st; };
__device__ __forceinline__ XcdBarrier xcd_barrier_post(unsigned* bar, volatile LAS unsigned* st) {
    XcdBarrier b; b.bar = bar; b.x = xb_xcc_id(); b.st = st;
    if (threadIdx.x == 0) (void)xb_add(&bar[XB_XCNT(b.x)], 1u);
    return b;
}
__device__ __forceinline__ void xcd_barrier_complete(unsigned* bar, unsigned x, unsigned& nloc, unsigned& nx) {
    const unsigned G = gridDim.x * gridDim.y * gridDim.z;
    unsigned sum, cnt, mine, sp = 0u;
    for (;;) {
        sum = 0u; cnt = 0u; mine = 0u;
#pragma unroll
        for (unsigned j = 0; j < 16; ++j) { const unsigned c = xb_ld(&bar[XB_XCNT(j)]); sum += c; cnt += (c > 0u) ? 1u : 0u; mine = (j == x) ? c : mine; }
        if (sum == G) break;
        __builtin_amdgcn_s_sleep(1);
        if ((++sp & 255u) == 0u) { if (xb_ld(&bar[XB_TMO])) break; if (sp > XB_SPIN_CAP) { atomicAdd(&bar[XB_TMO], 1u); break; } }
    }
    nloc = mine > 0u ? mine : 1u; nx = cnt > 0u ? cnt : 1u;
}
__device__ __forceinline__ void xcd_barrier(const XcdBarrier& b) {
    asm volatile("s_waitcnt vmcnt(0)" ::: "memory");
    __syncthreads();
    if (threadIdx.x == 0) {
        unsigned* bar = b.bar;
        __builtin_amdgcn_s_waitcnt(0);
        unsigned nloc = b.st[0], nx = b.st[1];
        if (nloc == 0u) { xcd_barrier_complete(bar, b.x, nloc, nx); b.st[0] = nloc; b.st[1] = nx; }
        const unsigned old = xb_add(&bar[XB_XSUB(b.x)], 1u);
        const unsigned gen = old / nloc;
        if (old + 1u == (gen + 1u) * nloc) {
            __builtin_amdgcn_fence(__ATOMIC_RELEASE, "agent");
            asm volatile("s_waitcnt vmcnt(0)" ::: "memory");
            const unsigned og = xb_add(&bar[XB_TOP], 1u);
            const unsigned tg = og / nx;
            if (og + 1u == (tg + 1u) * nx) xb_add(&bar[XB_TOPGEN], 1u);
            else XB_SPIN(xb_ld(&bar[XB_TOPGEN]) == tg, bar);
            __builtin_amdgcn_fence(__ATOMIC_ACQUIRE, "agent");
            xb_add(&bar[XB_XGEN(b.x)], 1u);
            asm volatile("s_waitcnt vmcnt(0)" ::: "memory");
        } else {
            XB_SPIN(xb_ld(&bar[XB_XGEN(b.x)]) == gen, bar);
            __builtin_amdgcn_fence(__ATOMIC_ACQUIRE, "agent");
            asm volatile("s_waitcnt vmcnt(0)" ::: "memory");
        }
    }
    __syncthreads();
}

struct Ctx { LAS unsigned char* lds; int tid, lane, wave, G, gw, NGW; };

__device__ __forceinline__ void transpose_item(const float* __restrict__ W, int K, int N, bf16_t* __restrict__ WT, LAS float* scr, int item, int lane) {
    const int nblk = N / 32, kb = item / nblk, nb = item % nblk, k0 = 64 * kb, n0 = 32 * nb;
#pragma unroll 8
    for (int i = 0; i < 32; ++i) { const int kk = 2 * i + (lane >> 5); scr[kk * 33 + (lane & 31)] = W[(size_t)(k0 + kk) * N + n0 + (lane & 31)]; }
    asm volatile("s_waitcnt lgkmcnt(0)" ::: "memory");
    const int c = lane & 7;
#pragma unroll
    for (int j = 0; j < 4; ++j) { const int n = (lane >> 3) + 8 * j; const LAS float* s = scr + (8 * c) * 33 + n;
        v4u o; o.x = pk2(s[0 * 33], s[1 * 33]); o.y = pk2(s[2 * 33], s[3 * 33]); o.z = pk2(s[4 * 33], s[5 * 33]); o.w = pk2(s[6 * 33], s[7 * 33]);
        *(v4u*)(WT + (size_t)(n0 + n) * K + k0 + 8 * c) = o; }
    asm volatile("s_waitcnt lgkmcnt(0)" ::: "memory");
}
__device__ __forceinline__ void embed_row(const float* __restrict__ xp, const float* __restrict__ xs, const float* __restrict__ meta, bf16_t* __restrict__ Hb, int row, int lane) {
    const float* src = nullptr;
    if (row < MP_PROMPT) { const int b = row / TPP, p = row % TPP; if (p >= PADF) { const int i = p - PADF; src = i < NMETA ? meta + (size_t)i * D : xp + ((size_t)b * SEQ + (i - NMETA)) * D; } }
    else src = xs + (size_t)(row - MP_PROMPT) * D;
    v2u* o = (v2u*)(Hb + (size_t)row * D) + lane;
#pragma unroll
    for (int j = 0; j < 4; ++j) { v2u w = {0u, 0u}; if (src) { const f32x4 v = ((const f32x4*)src)[lane + 64 * j]; w.x = pk2(v[0], v[1]); w.y = pk2(v[2], v[3]); } o[64 * j] = w; }
}
__device__ __forceinline__ void phase_prologue(const Ctx& c, const float* const* in, unsigned char* ws) {
    LAS float* scr = (LAS float*)(c.lds + c.wave * 16384);
    constexpr int I_ABI = 16 * (AB_IN / 32), I_O = 16 * 32, I_CDI = 16 * (CD_IN / 32), I_GU = 16 * (2 * FH / 32), I_DN = (FH / 64) * 32;
    constexpr int NITEMS = I_ABI + I_O + I_CDI + I_O + 2 * I_GU + 2 * I_DN;
    for (int it = c.gw; it < NITEMS; it += c.NGW) {
        int r = it;
        if (r < I_ABI) { transpose_item(in[8], D, AB_IN, (bf16_t*)(ws + WS_WAB_IN), scr, r, c.lane); continue; } r -= I_ABI;
        if (r < I_O) { transpose_item(in[12], D, D, (bf16_t*)(ws + WS_WAB_O), scr, r, c.lane); continue; } r -= I_O;
        if (r < I_CDI) { transpose_item(in[13], D, CD_IN, (bf16_t*)(ws + WS_WCD_IN), scr, r, c.lane); continue; } r -= I_CDI;
        if (r < I_O) { transpose_item(in[21], D, D, (bf16_t*)(ws + WS_WCD_O), scr, r, c.lane); continue; } r -= I_O;
        if (r < 2 * I_GU) { const int l = r / I_GU; transpose_item(in[26] + (size_t)l * D * 2 * FH, D, 2 * FH, (bf16_t*)(ws + WS_WGU) + (size_t)l * 2 * FH * D, scr, r % I_GU, c.lane); continue; } r -= 2 * I_GU;
        { const int l = r / I_DN; transpose_item(in[27] + (size_t)l * FH * D, FH, D, (bf16_t*)(ws + WS_WDN) + (size_t)l * D * FH, scr, r % I_DN, c.lane); }
    }
    for (int row = c.gw; row < MP; row += c.NGW) embed_row(in[0], in[1], in[7], (bf16_t*)(ws + WS_HB), row, c.lane);
    if (blockIdx.x == 0) { const int ch = c.tid; const float l0 = in[19][ch], l1 = in[19][512 + ch]; const float m = fmaxf(l0, l1); const float e0 = expf(l0 - m), e1 = expf(l1 - m); ((float*)(ws + WS_LB))[ch] = e1 / (e0 + e1); }
}

template <int EPI>
__device__ __forceinline__ void gemm_phase_simple(const Ctx& c, const bf16_t* __restrict__ A, const bf16_t* __restrict__ Bt, const bf16_t* __restrict__ Bt2, int N, int K, void* __restrict__ out, int ldc, const float* __restrict__ bias) {
    LAS bf16_t* As = (LAS bf16_t*)c.lds;
    LAS bf16_t* Bs = As + 256 * 40;
    LAS bf16_t* Bs2 = Bs + 128 * 40;
    const int tid = c.tid, lane = c.lane, wid = c.wave, wr = wid >> 1, wc = wid & 1, fr = lane & 15, fq = lane >> 4;
    const int nN = N / 128, ntiles = (MP / 256) * nN;
    const int sra = tid >> 1, sca = (tid & 1) * 16, srb = tid >> 2, scb = (tid & 3) * 8;
    for (int t = blockIdx.x; t < ntiles; t += c.G) {
        const int m0 = (t / nN) * 256, n0 = (t % nN) * 128;
        f32x4 acc[4][4], acc2[4][4];
#pragma unroll
        for (int m = 0; m < 4; ++m)
#pragma unroll
            for (int n = 0; n < 4; ++n) { acc[m][n] = (f32x4){0.f, 0.f, 0.f, 0.f}; acc2[m][n] = (f32x4){0.f, 0.f, 0.f, 0.f}; }
        const bf16_t* ap = A + (size_t)(m0 + sra) * K + sca;
        const bf16_t* bp = Bt + (size_t)(n0 + srb) * K + scb;
        const bf16_t* bp2 = EPI == 2 ? Bt2 + (size_t)(n0 + srb) * K + scb : nullptr;
        for (int k0 = 0; k0 < K; k0 += 32) {
            const v4u a0 = *(const v4u*)(ap + k0), a1 = *(const v4u*)(ap + k0 + 8);
            const v4u b0 = *(const v4u*)(bp + k0);
            v4u c0 = {0, 0, 0, 0};
            if (EPI == 2) c0 = *(const v4u*)(bp2 + k0);
            __syncthreads();
            *(LAS v4u*)(As + sra * 40 + sca) = a0; *(LAS v4u*)(As + sra * 40 + sca + 8) = a1;
            *(LAS v4u*)(Bs + srb * 40 + scb) = b0;
            if (EPI == 2) *(LAS v4u*)(Bs2 + srb * 40 + scb) = c0;
            __syncthreads();
            bf16x8 a[4], b[4];
#pragma unroll
            for (int m = 0; m < 4; ++m) a[m] = *(const LAS bf16x8*)(As + (wr * 64 + m * 16 + fr) * 40 + fq * 8);
#pragma unroll
            for (int n = 0; n < 4; ++n) b[n] = *(const LAS bf16x8*)(Bs + (wc * 64 + n * 16 + fr) * 40 + fq * 8);
#pragma unroll
            for (int m = 0; m < 4; ++m)
#pragma unroll
                for (int n = 0; n < 4; ++n) acc[m][n] = __builtin_amdgcn_mfma_f32_16x16x32_bf16(b[n], a[m], acc[m][n], 0, 0, 0);
            if (EPI == 2) {
#pragma unroll
                for (int n = 0; n < 4; ++n) b[n] = *(const LAS bf16x8*)(Bs2 + (wc * 64 + n * 16 + fr) * 40 + fq * 8);
#pragma unroll
                for (int m = 0; m < 4; ++m)
#pragma unroll
                    for (int n = 0; n < 4; ++n) acc2[m][n] = __builtin_amdgcn_mfma_f32_16x16x32_bf16(b[n], a[m], acc2[m][n], 0, 0, 0);
            }
        }
#pragma unroll
        for (int m = 0; m < 4; ++m)
#pragma unroll
            for (int n = 0; n < 4; ++n) {
                const int row = m0 + wr * 64 + m * 16 + fr, col = n0 + wc * 64 + n * 16 + 4 * fq;
                if (EPI == 0) { const f32x4 bv = *(const f32x4*)(bias + col); const f32x4 v = acc[m][n] + bv; v2u w; w.x = pk2(v[0], v[1]); w.y = pk2(v[2], v[3]); *(v2u*)((bf16_t*)out + (size_t)row * ldc + col) = w; }
                else if (EPI == 1) { *(f32x4*)((float*)out + (size_t)row * ldc + col) = acc[m][n]; }
                else { const f32x4 g = acc[m][n], u = acc2[m][n]; v2u w; w.x = pk2(siluf_(g[0]) * u[0], siluf_(g[1]) * u[1]); w.y = pk2(siluf_(g[2]) * u[2], siluf_(g[3]) * u[3]); *(v2u*)((bf16_t*)out + (size_t)row * ldc + col) = w; }
            }
    }
    __syncthreads();
}

__device__ __forceinline__ void phase_ln_residual(const Ctx& c, bf16_t* __restrict__ Hb, const float* __restrict__ mix, const float* __restrict__ g, const float* __restrict__ b, float* __restrict__ outf) {
    for (int row = c.gw; row < MP; row += c.NGW) {
        f32x4 y[4]; float s = 0.f;
        const v2u* hp = (const v2u*)(Hb + (size_t)row * D) + c.lane; const f32x4* mp = (const f32x4*)(mix + (size_t)row * D) + c.lane;
#pragma unroll
        for (int j = 0; j < 4; ++j) { const v2u hw = hp[64 * j]; const f32x4 mv = mp[64 * j];
            y[j][0] = ALPHA * __uint_as_float(hw.x << 16) + mv[0]; y[j][1] = ALPHA * __uint_as_float(hw.x & 0xffff0000u) + mv[1];
            y[j][2] = ALPHA * __uint_as_float(hw.y << 16) + mv[2]; y[j][3] = ALPHA * __uint_as_float(hw.y & 0xffff0000u) + mv[3];
            s += (y[j][0] + y[j][1]) + (y[j][2] + y[j][3]); }
        const float mu = wave_sum(s) * (1.0f / D); float q = 0.f;
#pragma unroll
        for (int j = 0; j < 4; ++j) { y[j] = y[j] - mu; q += (y[j][0] * y[j][0] + y[j][1] * y[j][1]) + (y[j][2] * y[j][2] + y[j][3] * y[j][3]); }
        const float rstd = rsqrtf(wave_sum(q) * (1.0f / D) + 1e-5f);
        float* op = nullptr;
        if (outf) { if (row < MP_PROMPT) { const int bb = row / TPP, p = row % TPP; if (p >= PADF + NMETA) op = outf + O_YP + ((size_t)bb * SEQ + (p - PADF - NMETA)) * D; } else op = outf + O_YS + (size_t)(row - MP_PROMPT) * D; }
        v2u* ho = (v2u*)(Hb + (size_t)row * D) + c.lane;
#pragma unroll
        for (int j = 0; j < 4; ++j) { const f32x4 gv = ((const f32x4*)g)[c.lane + 64 * j], bv = ((const f32x4*)b)[c.lane + 64 * j]; const f32x4 v = y[j] * rstd * gv + bv;
            v2u w; w.x = pk2(v[0], v[1]); w.y = pk2(v[2], v[3]); ho[64 * j] = w; if (op) ((f32x4*)op)[c.lane + 64 * j] = v; }
    }
}

__device__ __forceinline__ void phase_attn(const Ctx& c, const bf16_t* __restrict__ P0, const float* __restrict__ ck, const float* __restrict__ cv, const float* __restrict__ sinks, bf16_t* __restrict__ MIX) {
    LAS bf16_t* Ks = (LAS bf16_t*)c.lds;
    LAS bf16_t* Vs = Ks + 2 * 192 * 64;
    const int tid = c.tid;
    for (int T = blockIdx.x; T < NTILE64; T += c.G) {
        const bool samp = T >= NB * 65; const int s = T - NB * 65, cc = samp ? 0 : T % 65;
        const int row0 = T * 64;
        __syncthreads();
        for (int idx = tid; idx < 2 * 192 * 64; idx += NTHREADS) {
            const int kvh = idx / (192 * 64), rem = idx % (192 * 64), j = rem >> 6, d = rem & 63; bf16_t kv = 0, vv = 0;
            if (samp) { if (j < 128) { kv = f2bf(ck[(((size_t)s * 128 + j) * 2 + kvh) * 64 + d]); vv = f2bf(cv[(((size_t)s * 128 + j) * 2 + kvh) * 64 + d]); }
                        else { const size_t r = (size_t)(row0 + j - 128) * AB_IN; kv = P0[r + 512 + kvh * 64 + d]; vv = P0[r + 640 + kvh * 64 + d]; } }
            else { const int rel = (cc - 2) * 64 + j; if (rel >= PADF) { const size_t r = (size_t)(row0 - 128 + j) * AB_IN; kv = P0[r + 512 + kvh * 64 + d]; vv = P0[r + 640 + kvh * 64 + d]; } }
            Ks[idx] = kv; Vs[idx] = vv;
        }
        __syncthreads();
        const int kvh = tid >> 8, t = (tid & 255) >> 2, g = tid & 3, h = kvh * 4 + g;
        const LAS bf16_t* Kh = Ks + kvh * 192 * 64; const LAS bf16_t* Vh = Vs + kvh * 192 * 64;
        const float slope = exp2f(-(float)(h + 1)), sink = sinks[h];
        float q[64], o[64];
        { const bf16_t* qp = P0 + (size_t)(row0 + t) * AB_IN + h * 64;
#pragma unroll
          for (int d = 0; d < 64; ++d) { q[d] = bf2f(qp[d]) * 0.125f; o[d] = 0.f; } }
        float m = sink, l = 1.0f;
        const int jmin = samp ? 0 : ((cc - 2) * 64 >= PADF ? 0 : PADF - (cc - 2) * 64);
        for (int j = jmin; j < 192; ++j) {
            float sc = 0.f;
#pragma unroll
            for (int d = 0; d < 64; ++d) sc += q[d] * bf2f(Kh[j * 64 + d]);
            sc -= slope * fabsf((float)(128 + t - j));
            const float mn = fmaxf(m, sc), a = __expf(m - mn), p = __expf(sc - mn);
            l = l * a + p; m = mn;
#pragma unroll
            for (int d = 0; d < 64; ++d) o[d] = o[d] * a + p * bf2f(Vh[j * 64 + d]);
        }
        const float inv = 1.0f / l;
        bf16_t* op = MIX + (size_t)(row0 + t) * D + h * 64;
#pragma unroll
        for (int d = 0; d < 64; ++d) op[d] = f2bf(o[d] * inv);
    }
    __syncthreads();
}

__device__ __forceinline__ float convb_u(const bf16_t* __restrict__ P0, const float* __restrict__ stb, int row, int back, int ch) {
    if (row < MP_PROMPT) { const int p = row % TPP - back; if (p < PADF) return 0.f; const size_t r = (size_t)(row - back) * AB_IN; return bf2f(P0[r + 1280 + ch]) * bf2f(P0[r + 1792 + ch]); }
    const int s = (row - MP_PROMPT) / TS, t = (row - MP_PROMPT) % TS - back;
    if (t < 0) return stb[((size_t)s * 2 + (2 + t)) * 512 + ch];
    const size_t r = (size_t)(row - back) * AB_IN; return bf2f(P0[r + 1280 + ch]) * bf2f(P0[r + 1792 + ch]);
}
__device__ __forceinline__ void phase_convb(const Ctx& c, const bf16_t* __restrict__ P0, const float* __restrict__ stb, const float* __restrict__ w, bf16_t* __restrict__ MIX) {
    for (int row = c.gw; row < MP; row += c.NGW)
        for (int ch = c.lane; ch < 512; ch += 64) {
            const float cb = w[ch] * convb_u(P0, stb, row, 2, ch) + w[512 + ch] * convb_u(P0, stb, row, 1, ch) + w[1024 + ch] * convb_u(P0, stb, row, 0, ch);
            MIX[(size_t)row * D + 512 + ch] = f2bf(bf2f(P0[(size_t)row * AB_IN + 768 + ch]) * cb);
        }
}
__device__ __forceinline__ void phase_outs_l0(const Ctx& c, const bf16_t* __restrict__ P0, const float* __restrict__ ck, const float* __restrict__ cv, float* __restrict__ out) {
    for (int gid = blockIdx.x * NTHREADS + c.tid; gid < 131072; gid += c.G * NTHREADS) {
        if (gid < 65536) { const int b = gid >> 14, j = (gid >> 7) & 127, cc = gid & 127; const size_t r = (size_t)(b * TPP + PADF + TP - 128 + j) * AB_IN;
            out[O_KAP + gid] = bf2f(P0[r + 512 + cc]); out[O_VAP + gid] = bf2f(P0[r + 640 + cc]); }
        { const int s = gid >> 14, j = (gid >> 7) & 127, cc = gid & 127;
          if (j < 64) { out[O_KAS + gid] = ck[((size_t)s * 128 + 64 + j) * 128 + cc]; out[O_VAS + gid] = cv[((size_t)s * 128 + 64 + j) * 128 + cc]; }
          else { const size_t r = (size_t)(MP_PROMPT + s * 64 + (j - 64)) * AB_IN; out[O_KAS + gid] = bf2f(P0[r + 512 + cc]); out[O_VAS + gid] = bf2f(P0[r + 640 + cc]); } }
        if (gid < 4096) { const int b = gid >> 10, j = (gid >> 9) & 1, ch = gid & 511; const size_t r = (size_t)(b * TPP + PADF + TP - 2 + j) * AB_IN;
            out[O_CBP + gid] = bf2f(P0[r + 1280 + ch]) * bf2f(P0[r + 1792 + ch]); }
        if (gid < 8192) { const int s = gid >> 10, j = (gid >> 9) & 1, ch = gid & 511; const size_t r = (size_t)(MP_PROMPT + s * 64 + 62 + j) * AB_IN;
            out[O_CBS + gid] = bf2f(P0[r + 1280 + ch]) * bf2f(P0[r + 1792 + ch]); }
    }
}

__device__ __forceinline__ float convc_u(const bf16_t* __restrict__ P1, const float* __restrict__ stc, int row, int back, int ch) {
    if (row < MP_PROMPT) { const int p = row % TPP - back; if (p < PADF) return 0.f; const size_t r = (size_t)(row - back) * CD_IN; return bf2f(P1[r + ch]) * sigmoidf_(bf2f(P1[r + 512 + ch])); }
    const int s = (row - MP_PROMPT) / TS, t = (row - MP_PROMPT) % TS - back;
    if (t < 0) return stc[((size_t)s * 30 + (30 + t)) * 512 + ch];
    const size_t r = (size_t)(row - back) * CD_IN; return bf2f(P1[r + ch]) * sigmoidf_(bf2f(P1[r + 512 + ch]));
}
__device__ __forceinline__ void phase_convc(const Ctx& c, const bf16_t* __restrict__ P1, const float* __restrict__ stc, const float* __restrict__ w, const float* __restrict__ cb, const float* __restrict__ lg, const float* __restrict__ lbv, bf16_t* __restrict__ MIX) {
    for (int row = c.gw; row < MP; row += c.NGW) {
        float v[8]; float s = 0.f;
#pragma unroll
        for (int i = 0; i < 8; ++i) { const int ch = c.lane + 64 * i; float a = cb[ch];
            for (int j = 0; j < 31; ++j) a += w[j * 512 + ch] * convc_u(P1, stc, row, 30 - j, ch);
            v[i] = a; s += a; }
        const float mu = wave_sum(s) * (1.0f / 512.0f); float q = 0.f;
#pragma unroll
        for (int i = 0; i < 8; ++i) { v[i] -= mu; q += v[i] * v[i]; }
        const float rstd = rsqrtf(wave_sum(q) * (1.0f / 512.0f) + 1e-5f);
#pragma unroll
        for (int i = 0; i < 8; ++i) { const int ch = c.lane + 64 * i; MIX[(size_t)row * D + ch] = f2bf(siluf_(v[i] * rstd * lg[ch] + lbv[ch])); }
    }
}
__device__ __forceinline__ void phase_outs_l1(const Ctx& c, const bf16_t* __restrict__ P1, float* __restrict__ out) {
    for (int gid = blockIdx.x * NTHREADS + c.tid; gid < 122880; gid += c.G * NTHREADS) {
        if (gid < 61440) { const int b = gid / 15360, j = (gid / 512) % 30, ch = gid & 511; const size_t r = (size_t)(b * TPP + PADF + TP - 30 + j) * CD_IN;
            out[O_CCP + gid] = bf2f(P1[r + ch]) * sigmoidf_(bf2f(P1[r + 512 + ch])); }
        { const int s = gid / 15360, j = (gid / 512) % 30, ch = gid & 511; const size_t r = (size_t)(MP_PROMPT + s * 64 + 34 + j) * CD_IN;
          out[O_CCS + gid] = bf2f(P1[r + ch]) * sigmoidf_(bf2f(P1[r + 512 + ch])); }
    }
}

__device__ __forceinline__ void phase_hgrn(const Ctx& c, const bf16_t* __restrict__ P1, const float* __restrict__ lb, const float* __restrict__ st_in, float* __restrict__ obuf, float* __restrict__ out) {
    if (blockIdx.x >= 24) return;
    const int half = c.tid >> 8, tl = c.tid & 255, v = tl & 127, kh = tl >> 7;
    const int id = blockIdx.x * 2 + half;
    LAS float* sq = (LAS float*)c.lds + half * 2048;
    LAS float* sf = (LAS float*)c.lds + 4096 + half * 2048;
    LAS float* sk = (LAS float*)c.lds + 8192 + half * 2048;
    LAS float* so = (LAS float*)c.lds + 12288 + half * 4096;
    const bool samp = id >= 16; const int seq = samp ? (id - 16) >> 2 : id >> 2, h = id & 3;
    const int row0 = samp ? MP_PROMPT + seq * 64 : seq * TPP + PADF, ntok = samp ? 64 : TP;
    float S[64];
#pragma unroll
    for (int kk = 0; kk < 64; ++kk) S[kk] = samp ? st_in[(((size_t)seq * 4 + h) * 128 + kh * 64 + kk) * 128 + v] : 0.f;
    for (int t0 = 0; t0 < ntok; t0 += 16) {
        { const int tt = tl >> 4, kb = (tl & 15) * 8; const size_t r = (size_t)(row0 + t0 + tt) * CD_IN;
#pragma unroll
          for (int i = 0; i < 8; ++i) { const int k = kb + i; const float lbv = lb[h * 128 + k]; const float fg = lbv + (1.0f - lbv) * sigmoidf_(bf2f(P1[r + 1536 + h * 128 + k]));
              sq[tt * 128 + k] = bf2f(P1[r + 1024 + h * 128 + k]); sf[tt * 128 + k] = fg; sk[tt * 128 + k] = 1.0f - fg; } }
        __syncthreads();
        for (int tt = 0; tt < 16; ++tt) {
            const float vt = bf2f(P1[(size_t)(row0 + t0 + tt) * CD_IN + 2048 + h * 128 + v]);
            float a = 0.f;
#pragma unroll
            for (int kk = 0; kk < 64; ++kk) { const int k = kh * 64 + kk; S[kk] = sf[tt * 128 + k] * S[kk] + sk[tt * 128 + k] * vt; a += S[kk] * sq[tt * 128 + k]; }
            so[(tt * 2 + kh) * 128 + v] = a;
        }
        __syncthreads();
        for (int idx = tl; idx < 16 * 128; idx += 256) { const int tt = idx >> 7, v2 = idx & 127; obuf[(size_t)(row0 + t0 + tt) * 512 + h * 128 + v2] = so[(tt * 2) * 128 + v2] + so[(tt * 2 + 1) * 128 + v2]; }
    }
    float* op = out + (samp ? O_HGS : O_HGP) + (((size_t)seq * 4 + h) * 128 + kh * 64) * 128 + v;
#pragma unroll
    for (int kk = 0; kk < 64; ++kk) op[(size_t)kk * 128] = S[kk];
}
__device__ __forceinline__ void phase_readout(const Ctx& c, const float* __restrict__ obuf, const bf16_t* __restrict__ P1, const float* __restrict__ ng, bf16_t* __restrict__ MIX) {
    for (int row = c.gw; row < MP; row += c.NGW)
#pragma unroll
        for (int h = 0; h < 4; ++h) {
            const int c0 = h * 128 + c.lane * 2; const float a = obuf[(size_t)row * 512 + c0], b = obuf[(size_t)row * 512 + c0 + 1];
            const float r = rsqrtf(wave_sum(a * a + b * b) * (1.0f / 128.0f) + 1e-6f);
            const float g0 = bf2f(P1[(size_t)row * CD_IN + 2560 + c0]), g1 = bf2f(P1[(size_t)row * CD_IN + 2560 + c0 + 1]);
            *(unsigned*)(MIX + (size_t)row * D + 512 + c0) = pk2(a * r * ng[c0] * siluf_(g0), b * r * ng[c0 + 1] * siluf_(g1));
        }
}

template <int L>
__device__ __forceinline__ void layer_tail(const Ctx& c, const XcdBarrier& bar, const float* const* in, unsigned char* ws, float* out) {
    bf16_t* Hb = (bf16_t*)(ws + WS_HB); bf16_t* P = (bf16_t*)(ws + WS_P); bf16_t* MIX = (bf16_t*)(ws + WS_MIX);
    float* TMP1 = (float*)(ws + WS_P); float* TMP2 = (float*)(ws + WS_MIX);
    gemm_phase_simple<1>(c, MIX, (const bf16_t*)(ws + (L == 0 ? WS_WAB_O : WS_WCD_O)), nullptr, D, D, TMP1, D, nullptr);
    xcd_barrier(bar);
    phase_ln_residual(c, Hb, TMP1, in[22] + L * D, in[23] + L * D, nullptr);
    xcd_barrier(bar);
    const bf16_t* Wg = (const bf16_t*)(ws + WS_WGU) + (size_t)L * 2 * FH * D;
    gemm_phase_simple<2>(c, Hb, Wg, Wg + (size_t)FH * D, FH, D, P, FH, nullptr);
    xcd_barrier(bar);
    gemm_phase_simple<1>(c, P, (const bf16_t*)(ws + WS_WDN) + (size_t)L * D * FH, nullptr, D, FH, TMP2, D, nullptr);
    xcd_barrier(bar);
    phase_ln_residual(c, Hb, TMP2, in[24] + L * D, in[25] + L * D, L == 1 ? out : nullptr);
}

struct Params { const float* in[28]; float* out; unsigned char* ws; };
__global__ void __launch_bounds__(NTHREADS) fwd_megakernel(Params p) {
    extern __shared__ __attribute__((aligned(16))) unsigned char lds_raw[];
    Ctx c; c.lds = (LAS unsigned char*)lds_raw; c.tid = threadIdx.x; c.lane = c.tid & 63; c.wave = __builtin_amdgcn_readfirstlane(c.tid >> 6);
    c.G = gridDim.x; c.gw = blockIdx.x * NWAVES + c.wave; c.NGW = c.G * NWAVES;
    volatile LAS unsigned* ctl = (volatile LAS unsigned*)(c.lds + LDSCTL_OFF);
    if (c.tid < 64) ctl[c.tid] = 0u;
    __syncthreads();
    unsigned char* ws = p.ws; const float* const* in = p.in; float* out = p.out;
    XcdBarrier bar = xcd_barrier_post((unsigned*)(ws + WS_CTL) + CW_BAR, ctl + 8);
#define GRID_BAR() xcd_barrier(bar)
    bf16_t* Hb = (bf16_t*)(ws + WS_HB); bf16_t* P = (bf16_t*)(ws + WS_P); bf16_t* MIX = (bf16_t*)(ws + WS_MIX);
    float* SPARE = (float*)(ws + WS_SPARE); const float* lb = (const float*)(ws + WS_LB);

    phase_prologue(c, in, ws);
    GRID_BAR();
    gemm_phase_simple<0>(c, Hb, (const bf16_t*)(ws + WS_WAB_IN), nullptr, AB_IN, D, P, AB_IN, in[9]);
    GRID_BAR();
    phase_attn(c, P, in[2], in[3], in[10], MIX);
    phase_convb(c, P, in[4], in[11], MIX);
    phase_outs_l0(c, P, in[2], in[3], out);
    GRID_BAR();
    layer_tail<0>(c, bar, in, ws, out);
    GRID_BAR();
    gemm_phase_simple<0>(c, Hb, (const bf16_t*)(ws + WS_WCD_IN), nullptr, CD_IN, D, P, CD_IN, in[14]);
    GRID_BAR();
    phase_hgrn(c, P, lb, in[6], SPARE, out);
    phase_convc(c, P, in[5], in[15], in[16], in[17], in[18], MIX);
    phase_outs_l1(c, P, out);
    GRID_BAR();
    phase_readout(c, SPARE, P, in[20], MIX);
    GRID_BAR();
    layer_tail<1>(c, bar, in, ws, out);
}

extern "C" void kernel_launch(void* const* d_in, const int* in_sizes, int n_in, void* d_out, int out_size, void* d_ws, size_t ws_size, hipStream_t stream) {
    static int grid = 0;
    if (grid == 0) {
        if (n_in != 28 || ws_size < WS_END) { fprintf(stderr, "kernel_launch: unexpected n_in %d / ws_size %zu (need %zu)\n", n_in, ws_size, (size_t)WS_END); grid = -1; return; }
        int dev = 0, cus = 0, per_cu = 0;
        if (hipGetDevice(&dev) != hipSuccess || hipDeviceGetAttribute(&cus, hipDeviceAttributeMultiprocessorCount, dev) != hipSuccess) { grid = -1; return; }
        if (hipFuncSetAttribute((const void*)fwd_megakernel, hipFuncAttributeMaxDynamicSharedMemorySize, LDS_BYTES) != hipSuccess) { fprintf(stderr, "kernel_launch: hipFuncSetAttribute failed\n"); grid = -1; return; }
        if (hipOccupancyMaxActiveBlocksPerMultiprocessor(&per_cu, (const void*)fwd_megakernel, NTHREADS, LDS_BYTES) != hipSuccess || per_cu < 1) { fprintf(stderr, "kernel_launch: occupancy query says %d blocks per CU\n", per_cu); (void)hipGetLastError(); per_cu = 1; }
        grid = cus;
    }
    if (grid < 0) return;
    (void)hipMemsetAsync((char*)d_ws + WS_CTL, 0, CTL_ZERO_BYTES, stream);
    Params p{};
    for (int i = 0; i < 28; ++i) p.in[i] = (const float*)d_in[i];
    p.out = (float*)d_out; p.ws = (unsigned char*)d_ws;
    hipLaunchKernelGGL(fwd_megakernel, dim3(grid), dim3(NTHREADS), LDS_BYTES, stream, p);
}
```

```cpp
#include <hip/hip_runtime.h>
#include <cstdint>
#include <cstdio>

#define LAS __attribute__((address_space(3)))
typedef unsigned short bf16_t;
typedef short bf16x8 __attribute__((ext_vector_type(8)));
typedef float f32x4 __attribute__((ext_vector_type(4)));
typedef unsigned v4u __attribute__((ext_vector_type(4)));
typedef unsigned v2u __attribute__((ext_vector_type(2)));

constexpr int D = 1024;
constexpr int NB = 4, SEQ = 4096, NMETA = 16, TP = SEQ + NMETA  , PADF = 48, TPP = TP + PADF  ;
constexpr int NS = 8, TS = 64;
constexpr int MP_PROMPT = NB * TPP;
constexpr int MP = MP_PROMPT + NS * TS;
constexpr int NTILE64 = MP / 64;
constexpr int AB_IN = 2304, CD_IN = 3072, FH = 2816;
constexpr float ALPHA = 1.4142135623730951f;
constexpr int NTHREADS = 512, NWAVES = 8;

constexpr size_t O_YP = 0, O_YS = 16777216, O_KAP = 17301504, O_VAP = 17367040, O_CBP = 17432576, O_CCP = 17436672,
                 O_HGP = 17498112, O_KAS = 17760256, O_VAS = 17891328, O_CBS = 18022400, O_CCS = 18030592, O_HGS = 18153472;

constexpr size_t WS_CTL = 0, CTL_ZERO_BYTES = 65536;
constexpr size_t WS_WAB_IN = 1u << 20;
constexpr size_t WS_WAB_O = WS_WAB_IN + (size_t)AB_IN * D * 2;
constexpr size_t WS_WCD_IN = WS_WAB_O + (size_t)D * D * 2;
constexpr size_t WS_WCD_O = WS_WCD_IN + (size_t)CD_IN * D * 2;
constexpr size_t WS_WGU = WS_WCD_O + (size_t)D * D * 2;
constexpr size_t WS_WDN = WS_WGU + (size_t)2 * 2 * FH * D * 2;
constexpr size_t WS_LB = WS_WDN + (size_t)2 * D * FH * 2;
constexpr size_t WS_HB = WS_LB + 4096;
constexpr size_t WS_P = WS_HB + (size_t)MP * D * 2;
constexpr size_t WS_MIX = WS_P + (size_t)MP * CD_IN * 2;
constexpr size_t WS_SPARE = WS_MIX + (size_t)MP * D * 2;
constexpr size_t WS_END = WS_SPARE + (size_t)MP * 512 * 4;
static_assert(WS_END <= 268435456, "workspace map");
constexpr int CW_BAR = 4096;

constexpr int LDS_SCRATCH = 131072, LDSCTL_OFF = LDS_SCRATCH, LDS_BYTES = 147456;

__device__ __forceinline__ bf16_t f2bf(float f) { unsigned u = __float_as_uint(f); u += 0x7fffu + ((u >> 16) & 1u); return (bf16_t)(u >> 16); }
__device__ __forceinline__ unsigned pk2(float lo, float hi) { return (unsigned)f2bf(lo) | ((unsigned)f2bf(hi) << 16); }
__device__ __forceinline__ float bf2f(bf16_t h) { return __uint_as_float(((unsigned)h) << 16); }
__device__ __forceinline__ float sigmoidf_(float x) { return 1.0f / (1.0f + __expf(-x)); }
__device__ __forceinline__ float siluf_(float x) { return x / (1.0f + __expf(-x)); }
__device__ __forceinline__ float wave_sum(float v) {
#pragma unroll
    for (int o = 1; o < 64; o <<= 1) v += __shfl_xor(v, o);
    return v;
}

#define XB_TMO      128
#define XB_XCNT(j)  (256  + 64 * (j))
#define XB_XSUB(j)  (1280 + 64 * (j))
#define XB_XGEN(j)  (2304 + 64 * (j))
#define XB_TOP      3328
#define XB_TOPGEN   3392
#define XCD_BAR_WORDS 3456
#define XB_SPIN_CAP (1u << 18)
__device__ __forceinline__ unsigned xb_ld(unsigned* p)              { return __hip_atomic_load(p, __ATOMIC_RELAXED, __HIP_MEMORY_SCOPE_AGENT); }
__device__ __forceinline__ unsigned xb_add(unsigned* p, unsigned v) { return __hip_atomic_fetch_add(p, v, __ATOMIC_RELAXED, __HIP_MEMORY_SCOPE_AGENT); }
__device__ __forceinline__ unsigned xb_xcc_id() { return (unsigned)__builtin_amdgcn_s_getreg((3 << 11) | 20) & 0xFu; }
#define XB_SPIN(cond, bar) do { unsigned _sp = 0; while (cond) { __builtin_amdgcn_s_sleep(1); \
    if ((++_sp & 255u) == 0u) { if (xb_ld(&(bar)[XB_TMO])) break; if (_sp > XB_SPIN_CAP) { atomicAdd(&(bar)[XB_TMO], 1u); break; } } } } while (0)
struct XcdBarrier { unsigned* bar; unsigned x; volatile LAS unsigned* st; };
__device__ __forceinline__ XcdBarrier xcd_barrier_post(unsigned* bar, volatile LAS unsigned* st) {
    XcdBarrier b; b.bar = bar; b.x = xb_xcc_id(); b.st = st;
    if (threadIdx.x == 0) (void)xb_add(&bar[XB_XCNT(b.x)], 1u);
    return b;
}
__device__ __forceinline__ void xcd_barrier_complete(unsigned* bar, unsigned x, unsigned& nloc, unsigned& nx) {
    const unsigned G = gridDim.x * gridDim.y * gridDim.z;
    unsigned sum, cnt, mine, sp = 0u;
    for (;;) {
        sum = 0u; cnt = 0u; mine = 0u;
#pragma unroll
        for (unsigned j = 0; j < 16; ++j) { const unsigned c = xb_ld(&bar[XB_XCNT(j)]); sum += c; cnt += (c > 0u) ? 1u : 0u; mine = (j == x) ? c : mine; }
        if (sum == G) break;
        __builtin_amdgcn_s_sleep(1);
        if ((++sp & 255u) == 0u) { if (xb_ld(&bar[XB_TMO])) break; if (sp > XB_SPIN_CAP) { atomicAdd(&bar[XB_TMO], 1u); break; } }
    }
    nloc = mine > 0u ? mine : 1u; nx = cnt > 0u ? cnt : 1u;
}
__device__ __forceinline__ void xcd_barrier(const XcdBarrier& b) {
    asm volatile("s_waitcnt vmcnt(0)" ::: "memory");
    __syncthreads();
    if (threadIdx.x == 0) {
        unsigned* bar = b.bar;
        __builtin_amdgcn_s_waitcnt(0);
        unsigned nloc = b.st[0], nx = b.st[1];
        if (nloc == 0u) { xcd_barrier_complete(bar, b.x, nloc, nx); b.st[0] = nloc; b.st[1] = nx; }
        const unsigned old = xb_add(&bar[XB_XSUB(b.x)], 1u);
        const unsigned gen = old / nloc;
        if (old + 1u == (gen + 1u) * nloc) {
            __builtin_amdgcn_fence(__ATOMIC_RELEASE, "agent");
            asm volatile("s_waitcnt vmcnt(0)" ::: "memory");
            const unsigned og = xb_add(&bar[XB_TOP], 1u);
            const unsigned tg = og / nx;
            if (og + 1u == (tg + 1u) * nx) xb_add(&bar[XB_TOPGEN], 1u);
            else XB_SPIN(xb_ld(&bar[XB_TOPGEN]) == tg, bar);
            __builtin_amdgcn_fence(__ATOMIC_ACQUIRE, "agent");
            xb_add(&bar[XB_XGEN(b.x)], 1u);
            asm volatile("s_waitcnt vmcnt(0)" ::: "memory");
        } else {
            XB_SPIN(xb_ld(&bar[XB_XGEN(b.x)]) == gen, bar);
            __builtin_amdgcn_fence(__ATOMIC_ACQUIRE, "agent");
            asm volatile("s_waitcnt vmcnt(0)" ::: "memory");
        }
    }
    __syncthreads();
}

namespace pg8 {
#define PG8_LAS __attribute__((address_space(3)))
typedef unsigned short bf16_t;
typedef short bf16x8 __attribute__((ext_vector_type(8)));
typedef float f32x4 __attribute__((ext_vector_type(4)));
typedef unsigned u32x4 __attribute__((ext_vector_type(4)));
constexpr int BM = 256, BK = 64, HALF = 128, HTB = HALF * BK * 2  , STAGE_BYTES = 8 * HTB, NXCD = 8, WGM = 8;

__host__ __device__ __forceinline__ int lds_byte(int r, int c) { const int st = (r >> 4) * 2 + (c >> 5), rr = r & 15, cc = c & 31, ob = rr * 64 + cc * 2; return st * 1024 + (ob ^ (((ob >> 9) & 1) << 5)); }
__host__ __device__ __forceinline__ void stage_rc(int b, int& R, int& C) { const int st = b / 1024, sb = b % 1024, swz = sb ^ (((sb >> 9) & 1) << 5); R = (st >> 1) * 16 + swz / 64; C = (st & 1) * 32 + (swz % 64) / 2; }
__host__ __device__ __forceinline__ int perm32(int rho) { const int n = rho >> 4, i = rho & 15; return 8 * (i >> 2) + 4 * n + (i & 3); }

struct Unit { int pm, pn; };
struct Gemm { const bf16_t* A; const bf16_t* Bt; int M, N, K; };

struct StaticOrder {
    int nM, nN, nwg, G, c;
    __host__ __device__ void init(int M, int N, int G_, int c_) { nM = M / BM; nN = N / BM; nwg = nM * nN; G = G_; c = c_; }
    __host__ __device__ bool next(int i, Unit& u) const {
        const long L = (long)i * G + c; if (L >= nwg) return false;
        int wgid = (int)L; { const int q = nwg / NXCD, r = nwg % NXCD, xcd = wgid % NXCD, off = wgid / NXCD; wgid = (xcd < r ? xcd * (q + 1) : r * (q + 1) + (xcd - r) * q) + off; }
        const int nig = WGM * nN, gid = wgid / nig, fm = gid * WGM, gsz = (nM - fm) < WGM ? (nM - fm) : WGM;
        u.pm = fm + ((wgid % nig) % gsz); u.pn = (wgid % nig) / gsz; return true;
    }
    __device__ __forceinline__ void a_ready(const Unit&) const {}
    __device__ __forceinline__ void done(const Unit&) const {}
};

__device__ __forceinline__ unsigned cvt_pk_bf16(float lo, float hi) { unsigned r; asm volatile("v_cvt_pk_bf16_f32 %0, %1, %2" : "=v"(r) : "v"(lo), "v"(hi)); return r; }
template <int ACT  > struct EpiBf16 {
    static constexpr bool PERM = true, AFTER_DRAIN = false; static_assert(ACT == 0, "EpiBf16: ACT is 0 (none)");
    bf16_t* O; int ldc; const float* bias; int split_cols; size_t split_stride; float scale0;
    __device__ __forceinline__ void operator()(const f32x4 (&acc)[2][2][4][2], const Unit& u, int wr, int wc, int fr, int fq) const {
        const int row0 = u.pm * BM + wr * 64 + fr; int colt = u.pn * BM; bf16_t* base = O;
        float sc = 1.f; if (split_cols) { const int t = colt / split_cols; base += (size_t)t * split_stride; colt -= t * split_cols; if (t == 0) sc = scale0; }
        const int col0 = colt + wc * 32 + 8 * fq, bcol0 = u.pn * BM + wc * 32 + 8 * fq;
        f32x4 bv[2][2];
#pragma unroll
        for (int bj = 0; bj < 2; ++bj)
#pragma unroll
            for (int n = 0; n < 2; ++n) bv[bj][n] = bias ? *(const f32x4*)(bias + bcol0 + bj * HALF + 4 * n) : (f32x4){0.f, 0.f, 0.f, 0.f};
#pragma unroll
        for (int ai = 0; ai < 2; ++ai)
#pragma unroll
            for (int m = 0; m < 4; ++m) { bf16_t* rowp = base + (size_t)(row0 + ai * HALF + m * 16) * ldc + col0;
#pragma unroll
                for (int bj = 0; bj < 2; ++bj) { f32x4 v0 = acc[ai][bj][m][0] + bv[bj][0], v1 = acc[ai][bj][m][1] + bv[bj][1];
                    v0 = v0 * sc; v1 = v1 * sc; u32x4 w; w.x = cvt_pk_bf16(v0[0], v0[1]); w.y = cvt_pk_bf16(v0[2], v0[3]); w.z = cvt_pk_bf16(v1[0], v1[1]); w.w = cvt_pk_bf16(v1[2], v1[3]);
                    *(u32x4*)(rowp + bj * HALF) = w; } }
    }
};

struct EpiF32 {
    static constexpr bool PERM = false, AFTER_DRAIN = false;
    float* C; int ldc;
    __device__ __forceinline__ void operator()(const f32x4 (&acc)[2][2][4][2], const Unit& u, int wr, int wc, int fr, int fq) const {
        const int row0 = u.pm * BM + wr * 64 + fr, col0 = u.pn * BM + wc * 32 + 4 * fq;
#pragma unroll
        for (int ai = 0; ai < 2; ++ai)
#pragma unroll
            for (int m = 0; m < 4; ++m) { float* rowp = C + (size_t)(row0 + ai * HALF + m * 16) * ldc + col0;
#pragma unroll
                for (int bj = 0; bj < 2; ++bj)
#pragma unroll
                    for (int n = 0; n < 2; ++n) *(f32x4*)(rowp + bj * HALF + n * 16) = acc[ai][bj][m][n]; }
    }
};
struct EpiGU {
    static constexpr bool PERM = true, AFTER_DRAIN = false;
    bf16_t* O; int ldc;
    __device__ __forceinline__ void operator()(const f32x4 (&acc)[2][2][4][2], const Unit& u, int wr, int wc, int fr, int fq) const {
        const int row0 = u.pm * BM + wr * 64 + fr, col0 = u.pn * HALF + wc * 32 + 8 * fq;
#pragma unroll
        for (int ai = 0; ai < 2; ++ai)
#pragma unroll
            for (int m = 0; m < 4; ++m) { bf16_t* rowp = O + (size_t)(row0 + ai * HALF + m * 16) * ldc + col0;
                f32x4 h0, h1;
#pragma unroll
                for (int r = 0; r < 4; ++r) { const float g0 = acc[ai][0][m][0][r], g1 = acc[ai][0][m][1][r];
                    h0[r] = g0 * __builtin_amdgcn_rcpf(1.0f + __expf(-g0)) * acc[ai][1][m][0][r]; h1[r] = g1 * __builtin_amdgcn_rcpf(1.0f + __expf(-g1)) * acc[ai][1][m][1][r]; }
                u32x4 w; w.x = cvt_pk_bf16(h0[0], h0[1]); w.y = cvt_pk_bf16(h0[2], h0[3]); w.z = cvt_pk_bf16(h1[0], h1[1]); w.w = cvt_pk_bf16(h1[2], h1[3]);
                *(u32x4*)rowp = w; }
    }
};

template <class Epi, class Sched, bool ALIGN_EPI = false, bool SP2 = false>
__device__ __forceinline__ void gemm_phase(PG8_LAS unsigned char* lds, const Gemm g, const Sched& S, const Epi& E) {
    const int tid = threadIdx.x, wid = __builtin_amdgcn_readfirstlane(tid >> 6), lane = tid & 63, wr = wid >> 2, wc = wid & 3, fr = lane & 15, fq = lane >> 4;
    const int K = g.K, nt = K / BK;
    unsigned voffA[2], voffB[2];
#pragma unroll
    for (int i = 0; i < 2; ++i) { int R, C; stage_rc(tid * 16 + i * 8192, R, C); const int Rb = Epi::PERM ? ((R & ~31) + perm32(R & 31)) : R;
        voffA[i] = (unsigned)(R * K + C) * 2u; voffB[i] = (unsigned)(Rb * K + C) * 2u; }
    const size_t kstep = (size_t)(BK * 2);
    const size_t hstep = (size_t)HALF * K * 2;
    const size_t tstep = 2 * hstep;
    const unsigned ldsw = (unsigned)wid * 1024u;
    const int aoff = lds_byte(wr * 64 + fr, fq * 8), boff = lds_byte(wc * 32 + fr, fq * 8);
#define PG8_SA(b, h) (((b) * 2 + (h)) * HTB)
#define PG8_SB(b, h) ((4 + (b) * 2 + (h)) * HTB)
#define PG8_STAGE(bufoff, gbase, voff) do { _Pragma("unroll") for (int _i = 0; _i < 2; ++_i) \
        __builtin_amdgcn_global_load_lds((const unsigned*)((const char*)(gbase) + (voff)[_i]), (PG8_LAS unsigned*)(lds + (bufoff) + ldsw + _i * 8192), 16, 0, 0); } while (0)
#define PG8_LDA(dst, b, h) do { _Pragma("unroll") for (int m = 0; m < 4; ++m) _Pragma("unroll") for (int k = 0; k < 2; ++k) dst[m][k] = *(const PG8_LAS bf16x8*)(lds + PG8_SA(b, h) + aoff + m * 2048 + k * 1024); } while (0)
#define PG8_LDB(dst, b, h) do { _Pragma("unroll") for (int n = 0; n < 2; ++n) _Pragma("unroll") for (int k = 0; k < 2; ++k) dst[n][k] = *(const PG8_LAS bf16x8*)(lds + PG8_SB(b, h) + boff + n * 2048 + k * 1024); } while (0)
#define PG8_MMA(ai, bj, At, Bt) do { __builtin_amdgcn_s_setprio(1); _Pragma("unroll") for (int m = 0; m < 4; ++m) _Pragma("unroll") for (int n = 0; n < 2; ++n) _Pragma("unroll") for (int k = 0; k < 2; ++k) \
        acc[ai][bj][m][n] = __builtin_amdgcn_mfma_f32_16x16x32_bf16(Bt[n][k], At[m][k], acc[ai][bj][m][n], 0, 0, 0); __builtin_amdgcn_s_setprio(0); } while (0)
#define PG8_WAIT_V(n) asm volatile("s_waitcnt vmcnt(" #n ")" ::: "memory")
#define PG8_WAIT_L(n) asm volatile("s_waitcnt lgkmcnt(" #n ")" ::: "memory")
#define PG8_BAR __builtin_amdgcn_s_barrier()
#define PG8_SCHED __builtin_amdgcn_sched_barrier(0)
    Unit cur, nxt; int ui = 0;
    if (!S.next(0, cur)) return;
    f32x4 acc[2][2][4][2];
#pragma unroll
    for (int a = 0; a < 2; ++a)
#pragma unroll
        for (int b = 0; b < 2; ++b)
#pragma unroll
            for (int m = 0; m < 4; ++m)
#pragma unroll
                for (int n = 0; n < 2; ++n) acc[a][b][m][n] = (f32x4){0.f, 0.f, 0.f, 0.f};
    bf16x8 At[4][2], B0[2][2], B1[2][2];
    const char* cA = (const char*)g.A + (size_t)cur.pm * tstep; const char* cB = (const char*)g.Bt + (size_t)cur.pn * tstep;
    S.a_ready(cur);
    if constexpr (SP2) {
        PG8_STAGE(PG8_SB(0, 0), cB, voffB); PG8_STAGE(PG8_SB(0, 1), cB + hstep, voffB); PG8_STAGE(PG8_SA(0, 0), cA, voffA); PG8_STAGE(PG8_SA(0, 1), cA + hstep, voffA);
        if (wr == 1) PG8_BAR;
        PG8_WAIT_V(2); PG8_BAR;
        PG8_STAGE(PG8_SB(1, 0), cB + kstep, voffB); PG8_STAGE(PG8_SA(1, 0), cA + kstep, voffA); PG8_STAGE(PG8_SB(1, 1), cB + hstep + kstep, voffB);
        PG8_WAIT_V(6); PG8_BAR;
    } else {
        PG8_STAGE(PG8_SB(0, 0), cB, voffB); PG8_STAGE(PG8_SA(0, 0), cA, voffA); PG8_STAGE(PG8_SB(0, 1), cB + hstep, voffB); PG8_STAGE(PG8_SA(0, 1), cA + hstep, voffA);
        if (wr == 1) PG8_BAR;
        PG8_WAIT_V(4); PG8_BAR;
        PG8_STAGE(PG8_SB(1, 0), cB + kstep, voffB); PG8_STAGE(PG8_SA(1, 0), cA + kstep, voffA); PG8_STAGE(PG8_SB(1, 1), cB + hstep + kstep, voffB);
        PG8_WAIT_V(6); PG8_BAR;
    }
    for (;;) {
        const bool has_next = S.next(ui + 1, nxt);
        const char* nA = has_next ? (const char*)g.A + (size_t)nxt.pm * tstep : cA; const char* nB = has_next ? (const char*)g.Bt + (size_t)nxt.pn * tstep : cB;
        for (int t = 0; t < nt; t += 2) {
            const bool last = (t == nt - 2);
            const char* a1 = cA + (size_t)(t + 1) * kstep;
            const char* a2 = last ? nA : cA + (size_t)(t + 2) * kstep; const char* b2 = last ? nB : cB + (size_t)(t + 2) * kstep;
            const char* a3 = a2 + kstep; const char* b3 = b2 + kstep;
            if (last && has_next) S.a_ready(nxt);
            if constexpr (SP2) {
            PG8_LDB(B0, 0, 0); PG8_LDB(B1, 0, 1); PG8_SCHED; PG8_LDA(At, 0, 0); PG8_STAGE(PG8_SA(1, 1), a1 + hstep, voffA);
            PG8_WAIT_V(8); PG8_WAIT_L(0); PG8_BAR; PG8_MMA(0, 0, At, B0); PG8_MMA(0, 1, At, B1); PG8_BAR; PG8_SCHED;
            PG8_LDA(At, 0, 1); PG8_STAGE(PG8_SB(0, 0), b2, voffB); PG8_STAGE(PG8_SB(0, 1), b2 + hstep, voffB); PG8_STAGE(PG8_SA(0, 0), a2, voffA);
            PG8_WAIT_V(8); PG8_WAIT_L(0); PG8_BAR; PG8_MMA(1, 0, At, B0); PG8_MMA(1, 1, At, B1); PG8_BAR; PG8_SCHED;
            PG8_LDB(B0, 1, 0); PG8_LDB(B1, 1, 1); PG8_SCHED; PG8_LDA(At, 1, 0); PG8_STAGE(PG8_SA(0, 1), a2 + hstep, voffA);
            PG8_WAIT_V(8); PG8_WAIT_L(0); PG8_BAR; PG8_MMA(0, 0, At, B0); PG8_MMA(0, 1, At, B1); PG8_BAR; PG8_SCHED;
            PG8_LDA(At, 1, 1); PG8_STAGE(PG8_SB(1, 0), b3, voffB); PG8_STAGE(PG8_SB(1, 1), b3 + hstep, voffB); PG8_STAGE(PG8_SA(1, 0), a3, voffA);
            PG8_WAIT_V(8); PG8_WAIT_L(0); PG8_BAR; PG8_MMA(1, 0, At, B0); PG8_MMA(1, 1, At, B1); PG8_BAR; PG8_SCHED;
            } else {
            PG8_LDB(B0, 0, 0); PG8_SCHED; PG8_LDA(At, 0, 0); PG8_STAGE(PG8_SA(1, 1), a1 + hstep, voffA);
            PG8_WAIT_L(8); PG8_BAR; PG8_WAIT_L(0); PG8_MMA(0, 0, At, B0); PG8_BAR; PG8_SCHED;
            PG8_LDB(B1, 0, 1); PG8_STAGE(PG8_SB(0, 0), b2, voffB);
            PG8_BAR; PG8_WAIT_L(0); PG8_MMA(0, 1, At, B1); PG8_BAR;
            PG8_LDA(At, 0, 1); PG8_STAGE(PG8_SA(0, 0), a2, voffA);
            PG8_BAR; PG8_WAIT_L(0); PG8_MMA(1, 0, At, B0); PG8_BAR; PG8_SCHED;
            PG8_STAGE(PG8_SB(0, 1), b2 + hstep, voffB);
            PG8_WAIT_V(6); PG8_BAR; PG8_MMA(1, 1, At, B1); PG8_BAR;
            PG8_LDB(B0, 1, 0); PG8_SCHED; PG8_LDA(At, 1, 0); PG8_STAGE(PG8_SA(0, 1), a2 + hstep, voffA);
            PG8_WAIT_L(8); PG8_BAR; PG8_WAIT_L(0); PG8_MMA(0, 0, At, B0); PG8_BAR; PG8_SCHED;
            PG8_LDB(B1, 1, 1); PG8_STAGE(PG8_SB(1, 0), b3, voffB);
            PG8_BAR; PG8_WAIT_L(0); PG8_MMA(0, 1, At, B1); PG8_BAR;
            PG8_LDA(At, 1, 1); PG8_STAGE(PG8_SA(1, 0), a3, voffA);
            PG8_BAR; PG8_WAIT_L(0); PG8_MMA(1, 0, At, B0); PG8_BAR; PG8_SCHED;
            PG8_STAGE(PG8_SB(1, 1), b3 + hstep, voffB);
            PG8_WAIT_V(6); PG8_BAR; PG8_MMA(1, 1, At, B1); PG8_BAR;
            }
        }
        if constexpr (ALIGN_EPI) { if (wr == 0) PG8_BAR; }
        if constexpr (!Epi::AFTER_DRAIN) { E(acc, cur, wr, wc, fr, fq); S.done(cur); }
        if (!has_next) break;
#pragma unroll
        for (int a = 0; a < 2; ++a)
#pragma unroll
            for (int b = 0; b < 2; ++b)
#pragma unroll
                for (int m = 0; m < 4; ++m)
#pragma unroll
                    for (int n = 0; n < 2; ++n) acc[a][b][m][n] = (f32x4){0.f, 0.f, 0.f, 0.f};
        cur = nxt; cA = nA; cB = nB; ++ui;
        if constexpr (ALIGN_EPI) { if (wr == 1) PG8_BAR; }
    }
    PG8_WAIT_V(0);
    if constexpr (!ALIGN_EPI) { if (wr == 0) PG8_BAR; }
    PG8_BAR;
    if constexpr (Epi::AFTER_DRAIN) { E.fused(acc, cur, wr, wc, fr, fq, lds, wid, lane); S.done(cur); }
#undef PG8_SA
#undef PG8_SB
#undef PG8_STAGE
#undef PG8_LDA
#undef PG8_LDB
#undef PG8_MMA
#undef PG8_WAIT_V
#undef PG8_WAIT_L
#undef PG8_BAR
#undef PG8_SCHED
}
}


struct Ctx { LAS unsigned char* lds; int tid, lane, wave, G, gw, NGW; };

template <bool GU>
__device__ __forceinline__ void transpose_item(const float* __restrict__ W, int K, int N, bf16_t* __restrict__ WT, LAS float* scr, int item, int lane) {
    const int nblk = N / 32, kb = item / nblk, nb = item % nblk, k0 = 64 * kb, n0 = 32 * nb;
#pragma unroll 8
    for (int i = 0; i < 32; ++i) { const int kk = 2 * i + (lane >> 5); scr[kk * 33 + (lane & 31)] = W[(size_t)(k0 + kk) * N + n0 + (lane & 31)]; }
    asm volatile("s_waitcnt lgkmcnt(0)" ::: "memory");
    const int c = lane & 7;
#pragma unroll
    for (int j = 0; j < 4; ++j) { const int n = (lane >> 3) + 8 * j; const LAS float* s = scr + (8 * c) * 33 + n;
        v4u o; o.x = pk2(s[0 * 33], s[1 * 33]); o.y = pk2(s[2 * 33], s[3 * 33]); o.z = pk2(s[4 * 33], s[5 * 33]); o.w = pk2(s[6 * 33], s[7 * 33]);
        const int nn = n0 + n, orow = GU ? (nn < FH ? (nn >> 7) * 256 + (nn & 127) : ((nn - FH) >> 7) * 256 + 128 + ((nn - FH) & 127)) : nn;
        *(v4u*)(WT + (size_t)orow * K + k0 + 8 * c) = o; }
    asm volatile("s_waitcnt lgkmcnt(0)" ::: "memory");
}
__device__ __forceinline__ void embed_row(const float* __restrict__ xp, const float* __restrict__ xs, const float* __restrict__ meta, bf16_t* __restrict__ Hb, int row, int lane) {
    const float* src = nullptr;
    if (row < MP_PROMPT) { const int b = row / TPP, p = row % TPP; if (p >= PADF) { const int i = p - PADF; src = i < NMETA ? meta + (size_t)i * D : xp + ((size_t)b * SEQ + (i - NMETA)) * D; } }
    else src = xs + (size_t)(row - MP_PROMPT) * D;
    v2u* o = (v2u*)(Hb + (size_t)row * D) + lane;
#pragma unroll
    for (int j = 0; j < 4; ++j) { v2u w = {0u, 0u}; if (src) { const f32x4 v = ((const f32x4*)src)[lane + 64 * j]; w.x = pk2(v[0], v[1]); w.y = pk2(v[2], v[3]); } o[64 * j] = w; }
}
__device__ __forceinline__ void phase_prologue(const Ctx& c, const float* const* in, unsigned char* ws) {
    LAS float* scr = (LAS float*)(c.lds + c.wave * 16384);
    constexpr int I_ABI = 16 * (AB_IN / 32), I_O = 16 * 32, I_CDI = 16 * (CD_IN / 32), I_GU = 16 * (2 * FH / 32), I_DN = (FH / 64) * 32;
    constexpr int NITEMS = I_ABI + I_O + I_CDI + I_O + 2 * I_GU + 2 * I_DN;
    for (int it = c.gw; it < NITEMS; it += c.NGW) {
        int r = it;
        if (r < I_ABI) { transpose_item<false>(in[8], D, AB_IN, (bf16_t*)(ws + WS_WAB_IN), scr, r, c.lane); continue; } r -= I_ABI;
        if (r < I_O) { transpose_item<false>(in[12], D, D, (bf16_t*)(ws + WS_WAB_O), scr, r, c.lane); continue; } r -= I_O;
        if (r < I_CDI) { transpose_item<false>(in[13], D, CD_IN, (bf16_t*)(ws + WS_WCD_IN), scr, r, c.lane); continue; } r -= I_CDI;
        if (r < I_O) { transpose_item<false>(in[21], D, D, (bf16_t*)(ws + WS_WCD_O), scr, r, c.lane); continue; } r -= I_O;
        if (r < 2 * I_GU) { const int l = r / I_GU; transpose_item<true>(in[26] + (size_t)l * D * 2 * FH, D, 2 * FH, (bf16_t*)(ws + WS_WGU) + (size_t)l * 2 * FH * D, scr, r % I_GU, c.lane); continue; } r -= 2 * I_GU;
        { const int l = r / I_DN; transpose_item<false>(in[27] + (size_t)l * FH * D, FH, D, (bf16_t*)(ws + WS_WDN) + (size_t)l * D * FH, scr, r % I_DN, c.lane); }
    }
    for (int row = c.gw; row < MP; row += c.NGW) embed_row(in[0], in[1], in[7], (bf16_t*)(ws + WS_HB), row, c.lane);
    if (blockIdx.x == 0) { const int ch = c.tid; const float l0 = in[19][ch], l1 = in[19][512 + ch]; const float m = fmaxf(l0, l1); const float e0 = expf(l0 - m), e1 = expf(l1 - m); ((float*)(ws + WS_LB))[ch] = e1 / (e0 + e1); }
}

__device__ __forceinline__ void phase_ln_residual(const Ctx& c, bf16_t* __restrict__ Hb, const float* __restrict__ mix, const float* __restrict__ g, const float* __restrict__ b, float* __restrict__ outf) {
    for (int row = c.gw; row < MP; row += c.NGW) {
        f32x4 y[4]; float s = 0.f;
        const v2u* hp = (const v2u*)(Hb + (size_t)row * D) + c.lane; const f32x4* mp = (const f32x4*)(mix + (size_t)row * D) + c.lane;
#pragma unroll
        for (int j = 0; j < 4; ++j) { const v2u hw = hp[64 * j]; const f32x4 mv = mp[64 * j];
            y[j][0] = ALPHA * __uint_as_float(hw.x << 16) + mv[0]; y[j][1] = ALPHA * __uint_as_float(hw.x & 0xffff0000u) + mv[1];
            y[j][2] = ALPHA * __uint_as_float(hw.y << 16) + mv[2]; y[j][3] = ALPHA * __uint_as_float(hw.y & 0xffff0000u) + mv[3];
            s += (y[j][0] + y[j][1]) + (y[j][2] + y[j][3]); }
        const float mu = wave_sum(s) * (1.0f / D); float q = 0.f;
#pragma unroll
        for (int j = 0; j < 4; ++j) { y[j] = y[j] - mu; q += (y[j][0] * y[j][0] + y[j][1] * y[j][1]) + (y[j][2] * y[j][2] + y[j][3] * y[j][3]); }
        const float rstd = rsqrtf(wave_sum(q) * (1.0f / D) + 1e-5f);
        float* op = nullptr;
        if (outf) { if (row < MP_PROMPT) { const int bb = row / TPP, p = row % TPP; if (p >= PADF + NMETA) op = outf + O_YP + ((size_t)bb * SEQ + (p - PADF - NMETA)) * D; } else op = outf + O_YS + (size_t)(row - MP_PROMPT) * D; }
        v2u* ho = (v2u*)(Hb + (size_t)row * D) + c.lane;
#pragma unroll
        for (int j = 0; j < 4; ++j) { const f32x4 gv = ((const f32x4*)g)[c.lane + 64 * j], bv = ((const f32x4*)b)[c.lane + 64 * j]; const f32x4 v = y[j] * rstd * gv + bv;
            v2u w; w.x = pk2(v[0], v[1]); w.y = pk2(v[2], v[3]); ho[64 * j] = w; if (op) ((f32x4*)op)[c.lane + 64 * j] = v; }
    }
}

__device__ __forceinline__ void phase_attn(const Ctx& c, const bf16_t* __restrict__ P0, const float* __restrict__ ck, const float* __restrict__ cv, const float* __restrict__ sinks, bf16_t* __restrict__ MIX) {
    LAS bf16_t* Ks = (LAS bf16_t*)c.lds;
    LAS bf16_t* Vs = Ks + 2 * 192 * 64;
    const int tid = c.tid;
    for (int T = blockIdx.x; T < NTILE64; T += c.G) {
        const bool samp = T >= NB * 65; const int s = T - NB * 65, cc = samp ? 0 : T % 65;
        const int row0 = T * 64;
        __syncthreads();
        for (int idx = tid; idx < 2 * 192 * 64; idx += NTHREADS) {
            const int kvh = idx / (192 * 64), rem = idx % (192 * 64), j = rem >> 6, d = rem & 63; bf16_t kv = 0, vv = 0;
            if (samp) { if (j < 128) { kv = f2bf(ck[(((size_t)s * 128 + j) * 2 + kvh) * 64 + d]); vv = f2bf(cv[(((size_t)s * 128 + j) * 2 + kvh) * 64 + d]); }
                        else { const size_t r = (size_t)(row0 + j - 128) * AB_IN; kv = P0[r + 512 + kvh * 64 + d]; vv = P0[r + 640 + kvh * 64 + d]; } }
            else { const int rel = (cc - 2) * 64 + j; if (rel >= PADF) { const size_t r = (size_t)(row0 - 128 + j) * AB_IN; kv = P0[r + 512 + kvh * 64 + d]; vv = P0[r + 640 + kvh * 64 + d]; } }
            Ks[idx] = kv; Vs[idx] = vv;
        }
        __syncthreads();
        const int kvh = tid >> 8, t = (tid & 255) >> 2, g = tid & 3, h = kvh * 4 + g;
        const LAS bf16_t* Kh = Ks + kvh * 192 * 64; const LAS bf16_t* Vh = Vs + kvh * 192 * 64;
        const float slope = exp2f(-(float)(h + 1)), sink = sinks[h];
        float q[64], o[64];
        { const bf16_t* qp = P0 + (size_t)(row0 + t) * AB_IN + h * 64;
#pragma unroll
          for (int d = 0; d < 64; ++d) { q[d] = bf2f(qp[d]) * 0.125f; o[d] = 0.f; } }
        float m = sink, l = 1.0f;
        const int jmin = samp ? 0 : ((cc - 2) * 64 >= PADF ? 0 : PADF - (cc - 2) * 64);
        for (int j = jmin; j < 192; ++j) {
            float sc = 0.f;
#pragma unroll
            for (int d = 0; d < 64; ++d) sc += q[d] * bf2f(Kh[j * 64 + d]);
            sc -= slope * fabsf((float)(128 + t - j));
            const float mn = fmaxf(m, sc), a = __expf(m - mn), p = __expf(sc - mn);
            l = l * a + p; m = mn;
#pragma unroll
            for (int d = 0; d < 64; ++d) o[d] = o[d] * a + p * bf2f(Vh[j * 64 + d]);
        }
        const float inv = 1.0f / l;
        bf16_t* op = MIX + (size_t)(row0 + t) * D + h * 64;
#pragma unroll
        for (int d = 0; d < 64; ++d) op[d] = f2bf(o[d] * inv);
    }
    __syncthreads();
}

__device__ __forceinline__ float convb_u(const bf16_t* __restrict__ P0, const float* __restrict__ stb, int row, int back, int ch) {
    if (row < MP_PROMPT) { const int p = row % TPP - back; if (p < PADF) return 0.f; const size_t r = (size_t)(row - back) * AB_IN; return bf2f(P0[r + 1280 + ch]) * bf2f(P0[r + 1792 + ch]); }
    const int s = (row - MP_PROMPT) / TS, t = (row - MP_PROMPT) % TS - back;
    if (t < 0) return stb[((size_t)s * 2 + (2 + t)) * 512 + ch];
    const size_t r = (size_t)(row - back) * AB_IN; return bf2f(P0[r + 1280 + ch]) * bf2f(P0[r + 1792 + ch]);
}
__device__ __forceinline__ void phase_convb(const Ctx& c, const bf16_t* __restrict__ P0, const float* __restrict__ stb, const float* __restrict__ w, bf16_t* __restrict__ MIX) {
    for (int row = c.gw; row < MP; row += c.NGW)
        for (int ch = c.lane; ch < 512; ch += 64) {
            const float cb = w[ch] * convb_u(P0, stb, row, 2, ch) + w[512 + ch] * convb_u(P0, stb, row, 1, ch) + w[1024 + ch] * convb_u(P0, stb, row, 0, ch);
            MIX[(size_t)row * D + 512 + ch] = f2bf(bf2f(P0[(size_t)row * AB_IN + 768 + ch]) * cb);
        }
}
__device__ __forceinline__ void phase_outs_l0(const Ctx& c, const bf16_t* __restrict__ P0, const float* __restrict__ ck, const float* __restrict__ cv, float* __restrict__ out) {
    for (int gid = blockIdx.x * NTHREADS + c.tid; gid < 131072; gid += c.G * NTHREADS) {
        if (gid < 65536) { const int b = gid >> 14, j = (gid >> 7) & 127, cc = gid & 127; const size_t r = (size_t)(b * TPP + PADF + TP - 128 + j) * AB_IN;
            out[O_KAP + gid] = bf2f(P0[r + 512 + cc]); out[O_VAP + gid] = bf2f(P0[r + 640 + cc]); }
        { const int s = gid >> 14, j = (gid >> 7) & 127, cc = gid & 127;
          if (j < 64) { out[O_KAS + gid] = ck[((size_t)s * 128 + 64 + j) * 128 + cc]; out[O_VAS + gid] = cv[((size_t)s * 128 + 64 + j) * 128 + cc]; }
          else { const size_t r = (size_t)(MP_PROMPT + s * 64 + (j - 64)) * AB_IN; out[O_KAS + gid] = bf2f(P0[r + 512 + cc]); out[O_VAS + gid] = bf2f(P0[r + 640 + cc]); } }
        if (gid < 4096) { const int b = gid >> 10, j = (gid >> 9) & 1, ch = gid & 511; const size_t r = (size_t)(b * TPP + PADF + TP - 2 + j) * AB_IN;
            out[O_CBP + gid] = bf2f(P0[r + 1280 + ch]) * bf2f(P0[r + 1792 + ch]); }
        if (gid < 8192) { const int s = gid >> 10, j = (gid >> 9) & 1, ch = gid & 511; const size_t r = (size_t)(MP_PROMPT + s * 64 + 62 + j) * AB_IN;
            out[O_CBS + gid] = bf2f(P0[r + 1280 + ch]) * bf2f(P0[r + 1792 + ch]); }
    }
}

__device__ __forceinline__ float convc_u(const bf16_t* __restrict__ P1, const float* __restrict__ stc, int row, int back, int ch) {
    if (row < MP_PROMPT) { const int p = row % TPP - back; if (p < PADF) return 0.f; const size_t r = (size_t)(row - back) * CD_IN; return bf2f(P1[r + ch]) * sigmoidf_(bf2f(P1[r + 512 + ch])); }
    const int s = (row - MP_PROMPT) / TS, t = (row - MP_PROMPT) % TS - back;
    if (t < 0) return stc[((size_t)s * 30 + (30 + t)) * 512 + ch];
    const size_t r = (size_t)(row - back) * CD_IN; return bf2f(P1[r + ch]) * sigmoidf_(bf2f(P1[r + 512 + ch]));
}
__device__ __forceinline__ void phase_convc(const Ctx& c, const bf16_t* __restrict__ P1, const float* __restrict__ stc, const float* __restrict__ w, const float* __restrict__ cb, const float* __restrict__ lg, const float* __restrict__ lbv, bf16_t* __restrict__ MIX) {
    for (int row = c.gw; row < MP; row += c.NGW) {
        float v[8]; float s = 0.f;
#pragma unroll
        for (int i = 0; i < 8; ++i) { const int ch = c.lane + 64 * i; float a = cb[ch];
            for (int j = 0; j < 31; ++j) a += w[j * 512 + ch] * convc_u(P1, stc, row, 30 - j, ch);
            v[i] = a; s += a; }
        const float mu = wave_sum(s) * (1.0f / 512.0f); float q = 0.f;
#pragma unroll
        for (int i = 0; i < 8; ++i) { v[i] -= mu; q += v[i] * v[i]; }
        const float rstd = rsqrtf(wave_sum(q) * (1.0f / 512.0f) + 1e-5f);
#pragma unroll
        for (int i = 0; i < 8; ++i) { const int ch = c.lane + 64 * i; MIX[(size_t)row * D + ch] = f2bf(siluf_(v[i] * rstd * lg[ch] + lbv[ch])); }
    }
}
__device__ __forceinline__ void phase_outs_l1(const Ctx& c, const bf16_t* __restrict__ P1, float* __restrict__ out) {
    for (int gid = blockIdx.x * NTHREADS + c.tid; gid < 122880; gid += c.G * NTHREADS) {
        if (gid < 61440) { const int b = gid / 15360, j = (gid / 512) % 30, ch = gid & 511; const size_t r = (size_t)(b * TPP + PADF + TP - 30 + j) * CD_IN;
            out[O_CCP + gid] = bf2f(P1[r + ch]) * sigmoidf_(bf2f(P1[r + 512 + ch])); }
        { const int s = gid / 15360, j = (gid / 512) % 30, ch = gid & 511; const size_t r = (size_t)(MP_PROMPT + s * 64 + 34 + j) * CD_IN;
          out[O_CCS + gid] = bf2f(P1[r + ch]) * sigmoidf_(bf2f(P1[r + 512 + ch])); }
    }
}

__device__ __forceinline__ void phase_hgrn(const Ctx& c, const bf16_t* __restrict__ P1, const float* __restrict__ lb, const float* __restrict__ st_in, float* __restrict__ obuf, float* __restrict__ out) {
    if (blockIdx.x >= 24) return;
    const int half = c.tid >> 8, tl = c.tid & 255, v = tl & 127, kh = tl >> 7;
    const int id = blockIdx.x * 2 + half;
    LAS float* sq = (LAS float*)c.lds + half * 2048;
    LAS float* sf = (LAS float*)c.lds + 4096 + half * 2048;
    LAS float* sk = (LAS float*)c.lds + 8192 + half * 2048;
    LAS float* so = (LAS float*)c.lds + 12288 + half * 4096;
    const bool samp = id >= 16; const int seq = samp ? (id - 16) >> 2 : id >> 2, h = id & 3;
    const int row0 = samp ? MP_PROMPT + seq * 64 : seq * TPP + PADF, ntok = samp ? 64 : TP;
    float S[64];
#pragma unroll
    for (int kk = 0; kk < 64; ++kk) S[kk] = samp ? st_in[(((size_t)seq * 4 + h) * 128 + kh * 64 + kk) * 128 + v] : 0.f;
    for (int t0 = 0; t0 < ntok; t0 += 16) {
        { const int tt = tl >> 4, kb = (tl & 15) * 8; const size_t r = (size_t)(row0 + t0 + tt) * CD_IN;
#pragma unroll
          for (int i = 0; i < 8; ++i) { const int k = kb + i; const float lbv = lb[h * 128 + k]; const float fg = lbv + (1.0f - lbv) * sigmoidf_(bf2f(P1[r + 1536 + h * 128 + k]));
              sq[tt * 128 + k] = bf2f(P1[r + 1024 + h * 128 + k]); sf[tt * 128 + k] = fg; sk[tt * 128 + k] = 1.0f - fg; } }
        __syncthreads();
        for (int tt = 0; tt < 16; ++tt) {
            const float vt = bf2f(P1[(size_t)(row0 + t0 + tt) * CD_IN + 2048 + h * 128 + v]);
            float a = 0.f;
#pragma unroll
            for (int kk = 0; kk < 64; ++kk) { const int k = kh * 64 + kk; S[kk] = sf[tt * 128 + k] * S[kk] + sk[tt * 128 + k] * vt; a += S[kk] * sq[tt * 128 + k]; }
            so[(tt * 2 + kh) * 128 + v] = a;
        }
        __syncthreads();
        for (int idx = tl; idx < 16 * 128; idx += 256) { const int tt = idx >> 7, v2 = idx & 127; obuf[(size_t)(row0 + t0 + tt) * 512 + h * 128 + v2] = so[(tt * 2) * 128 + v2] + so[(tt * 2 + 1) * 128 + v2]; }
    }
    float* op = out + (samp ? O_HGS : O_HGP) + (((size_t)seq * 4 + h) * 128 + kh * 64) * 128 + v;
#pragma unroll
    for (int kk = 0; kk < 64; ++kk) op[(size_t)kk * 128] = S[kk];
}
__device__ __forceinline__ void phase_readout(const Ctx& c, const float* __restrict__ obuf, const bf16_t* __restrict__ P1, const float* __restrict__ ng, bf16_t* __restrict__ MIX) {
    for (int row = c.gw; row < MP; row += c.NGW)
#pragma unroll
        for (int h = 0; h < 4; ++h) {
            const int c0 = h * 128 + c.lane * 2; const float a = obuf[(size_t)row * 512 + c0], b = obuf[(size_t)row * 512 + c0 + 1];
            const float r = rsqrtf(wave_sum(a * a + b * b) * (1.0f / 128.0f) + 1e-6f);
            const float g0 = bf2f(P1[(size_t)row * CD_IN + 2560 + c0]), g1 = bf2f(P1[(size_t)row * CD_IN + 2560 + c0 + 1]);
            *(unsigned*)(MIX + (size_t)row * D + 512 + c0) = pk2(a * r * ng[c0] * siluf_(g0), b * r * ng[c0 + 1] * siluf_(g1));
        }
}

template <int L>
__device__ __forceinline__ void layer_tail(const Ctx& c, const XcdBarrier& bar, const float* const* in, unsigned char* ws, float* out) {
    bf16_t* Hb = (bf16_t*)(ws + WS_HB); bf16_t* P = (bf16_t*)(ws + WS_P); bf16_t* MIX = (bf16_t*)(ws + WS_MIX);
    float* TMP1 = (float*)(ws + WS_P); float* TMP2 = (float*)(ws + WS_MIX);
    { pg8::Gemm g{MIX, (const bf16_t*)(ws + (L == 0 ? WS_WAB_O : WS_WCD_O)), MP, D, D}; pg8::StaticOrder S; S.init(MP, D, c.G, (int)blockIdx.x); pg8::EpiF32 E{TMP1, D};
      pg8::gemm_phase<pg8::EpiF32, pg8::StaticOrder, true, true>(c.lds, g, S, E); }
    xcd_barrier(bar);
    phase_ln_residual(c, Hb, TMP1, in[22] + L * D, in[23] + L * D, nullptr);
    xcd_barrier(bar);
    const bf16_t* Wg = (const bf16_t*)(ws + WS_WGU) + (size_t)L * 2 * FH * D;
    { pg8::Gemm g{Hb, Wg, MP, 2 * FH, D}; pg8::StaticOrder S; S.init(MP, 2 * FH, c.G, (int)blockIdx.x); pg8::EpiGU E{P, FH};
      pg8::gemm_phase<pg8::EpiGU, pg8::StaticOrder, true, true>(c.lds, g, S, E); }
    xcd_barrier(bar);
    { pg8::Gemm g{P, (const bf16_t*)(ws + WS_WDN) + (size_t)L * D * FH, MP, D, FH}; pg8::StaticOrder S; S.init(MP, D, c.G, (int)blockIdx.x); pg8::EpiF32 E{TMP2, D};
      pg8::gemm_phase<pg8::EpiF32, pg8::StaticOrder, true, true>(c.lds, g, S, E); }
    xcd_barrier(bar);
    phase_ln_residual(c, Hb, TMP2, in[24] + L * D, in[25] + L * D, L == 1 ? out : nullptr);
}

struct Params { const float* in[28]; float* out; unsigned char* ws; };
__global__ void __launch_bounds__(NTHREADS) fwd_megakernel(Params p) {
    extern __shared__ __attribute__((aligned(16))) unsigned char lds_raw[];
    Ctx c; c.lds = (LAS unsigned char*)lds_raw; c.tid = threadIdx.x; c.lane = c.tid & 63; c.wave = __builtin_amdgcn_readfirstlane(c.tid >> 6);
    c.G = gridDim.x; c.gw = blockIdx.x * NWAVES + c.wave; c.NGW = c.G * NWAVES;
    volatile LAS unsigned* ctl = (volatile LAS unsigned*)(c.lds + LDSCTL_OFF);
    if (c.tid < 64) ctl[c.tid] = 0u;
    __syncthreads();
    unsigned char* ws = p.ws; const float* const* in = p.in; float* out = p.out;
    XcdBarrier bar = xcd_barrier_post((unsigned*)(ws + WS_CTL) + CW_BAR, ctl + 8);
#define GRID_BAR() xcd_barrier(bar)
    bf16_t* Hb = (bf16_t*)(ws + WS_HB); bf16_t* P = (bf16_t*)(ws + WS_P); bf16_t* MIX = (bf16_t*)(ws + WS_MIX);
    float* SPARE = (float*)(ws + WS_SPARE); const float* lb = (const float*)(ws + WS_LB);

    phase_prologue(c, in, ws);
    GRID_BAR();
    { pg8::Gemm g{Hb, (const bf16_t*)(ws + WS_WAB_IN), MP, AB_IN, D}; pg8::StaticOrder S; S.init(MP, AB_IN, c.G, (int)blockIdx.x); pg8::EpiBf16<0> E{P, AB_IN, in[9], 0, 0, 1.f};
      pg8::gemm_phase<pg8::EpiBf16<0>, pg8::StaticOrder, true, true>(c.lds, g, S, E); }
    GRID_BAR();
    phase_attn(c, P, in[2], in[3], in[10], MIX);
    phase_convb(c, P, in[4], in[11], MIX);
    phase_outs_l0(c, P, in[2], in[3], out);
    GRID_BAR();
    layer_tail<0>(c, bar, in, ws, out);
    GRID_BAR();
    { pg8::Gemm g{Hb, (const bf16_t*)(ws + WS_WCD_IN), MP, CD_IN, D}; pg8::StaticOrder S; S.init(MP, CD_IN, c.G, (int)blockIdx.x); pg8::EpiBf16<0> E{P, CD_IN, in[14], 0, 0, 1.f};
      pg8::gemm_phase<pg8::EpiBf16<0>, pg8::StaticOrder, true, true>(c.lds, g, S, E); }
    GRID_BAR();
    phase_hgrn(c, P, lb, in[6], SPARE, out);
    phase_convc(c, P, in[5], in[15], in[16], in[17], in[18], MIX);
    phase_outs_l1(c, P, out);
    GRID_BAR();
    phase_readout(c, SPARE, P, in[20], MIX);
    GRID_BAR();
    layer_tail<1>(c, bar, in, ws, out);
}

extern "C" void kernel_launch(void* const* d_in, const int* in_sizes, int n_in, void* d_out, int out_size, void* d_ws, size_t ws_size, hipStream_t stream) {
    static int grid = 0;
    if (grid == 0) {
        if (n_in != 28 || ws_size < WS_END) { fprintf(stderr, "kernel_launch: unexpected n_in %d / ws_size %zu (need %zu)\n", n_in, ws_size, (size_t)WS_END); grid = -1; return; }
        int dev = 0, cus = 0, per_cu = 0;
        if (hipGetDevice(&dev) != hipSuccess || hipDeviceGetAttribute(&cus, hipDeviceAttributeMultiprocessorCount, dev) != hipSuccess) { grid = -1; return; }
        if (hipFuncSetAttribute((const void*)fwd_megakernel, hipFuncAttributeMaxDynamicSharedMemorySize, LDS_BYTES) != hipSuccess) { fprintf(stderr, "kernel_launch: hipFuncSetAttribute failed\n"); grid = -1; return; }
        if (hipOccupancyMaxActiveBlocksPerMultiprocessor(&per_cu, (const void*)fwd_megakernel, NTHREADS, LDS_BYTES) != hipSuccess || per_cu < 1) { fprintf(stderr, "kernel_launch: occupancy query says %d blocks per CU\n", per_cu); (void)hipGetLastError(); per_cu = 1; }
        grid = cus;
    }
    if (grid < 0) return;
    (void)hipMemsetAsync((char*)d_ws + WS_CTL, 0, CTL_ZERO_BYTES, stream);
    Params p{};
    for (int i = 0; i < 28; ++i) p.in[i] = (const float*)d_in[i];
    p.out = (float*)d_out; p.ws = (unsigned char*)d_ws;
    hipLaunchKernelGGL(fwd_megakernel, dim3(grid), dim3(NTHREADS), LDS_BYTES, stream, p);
}
```

```cpp
#include <hip/hip_runtime.h>
#include <cstdint>
#include <cstdio>

#define LAS __attribute__((address_space(3)))
typedef unsigned short bf16_t;
typedef short bf16x8 __attribute__((ext_vector_type(8)));
typedef float f32x4 __attribute__((ext_vector_type(4)));
typedef unsigned v4u __attribute__((ext_vector_type(4)));
typedef unsigned v2u __attribute__((ext_vector_type(2)));

constexpr int D = 1024;
constexpr int NB = 4, SEQ = 4096, NMETA = 16, TP = SEQ + NMETA  , PADF = 48, TPP = TP + PADF  ;
constexpr int NS = 8, TS = 64;
constexpr int MP_PROMPT = NB * TPP;
constexpr int MP = MP_PROMPT + NS * TS;
constexpr int NTILE64 = MP / 64;
constexpr int AB_IN = 2304, CD_IN = 3072, FH = 2816;
constexpr float ALPHA = 1.4142135623730951f;
constexpr int NTHREADS = 512, NWAVES = 8;

constexpr size_t O_YP = 0, O_YS = 16777216, O_KAP = 17301504, O_VAP = 17367040, O_CBP = 17432576, O_CCP = 17436672,
                 O_HGP = 17498112, O_KAS = 17760256, O_VAS = 17891328, O_CBS = 18022400, O_CCS = 18030592, O_HGS = 18153472;

constexpr size_t WS_CTL = 0, CTL_ZERO_BYTES = 65536;
constexpr size_t WS_WAB_IN = 1u << 20;
constexpr size_t WS_WAB_O = WS_WAB_IN + (size_t)AB_IN * D * 2;
constexpr size_t WS_WCD_IN = WS_WAB_O + (size_t)D * D * 2;
constexpr size_t WS_WCD_O = WS_WCD_IN + (size_t)CD_IN * D * 2;
constexpr size_t WS_WGU = WS_WCD_O + (size_t)D * D * 2;
constexpr size_t WS_WDN = WS_WGU + (size_t)2 * 2 * FH * D * 2;
constexpr size_t WS_LB = WS_WDN + (size_t)2 * D * FH * 2;
constexpr size_t WS_HB = WS_LB + 4096;
constexpr size_t WS_P = WS_HB + (size_t)MP * D * 2;
constexpr size_t WS_MIX = WS_P + (size_t)MP * CD_IN * 2;
constexpr size_t WS_SPARE = WS_MIX + (size_t)MP * D * 2;
constexpr size_t WS_END = WS_SPARE + (size_t)MP * 512 * 4;
static_assert(WS_END <= 268435456, "workspace map");
constexpr int CW_BAR = 4096;

constexpr int LDS_SCRATCH = 131072, LDSCTL_OFF = LDS_SCRATCH, LDS_BYTES = 147456;

__device__ __forceinline__ bf16_t f2bf(float f) { unsigned u = __float_as_uint(f); u += 0x7fffu + ((u >> 16) & 1u); return (bf16_t)(u >> 16); }
__device__ __forceinline__ unsigned pk2(float lo, float hi) { return (unsigned)f2bf(lo) | ((unsigned)f2bf(hi) << 16); }
__device__ __forceinline__ float bf2f(bf16_t h) { return __uint_as_float(((unsigned)h) << 16); }
__device__ __forceinline__ float sigmoidf_(float x) { return 1.0f / (1.0f + __expf(-x)); }
__device__ __forceinline__ float siluf_(float x) { return x / (1.0f + __expf(-x)); }
__device__ __forceinline__ float wave_sum(float v) {
#pragma unroll
    for (int o = 1; o < 64; o <<= 1) v += __shfl_xor(v, o);
    return v;
}

#define XB_TMO      128
#define XB_XCNT(j)  (256  + 64 * (j))
#define XB_XSUB(j)  (1280 + 64 * (j))
#define XB_XGEN(j)  (2304 + 64 * (j))
#define XB_TOP      3328
#define XB_TOPGEN   3392
#define XCD_BAR_WORDS 3456
#define XB_SPIN_CAP (1u << 18)
__device__ __forceinline__ unsigned xb_ld(unsigned* p)              { return __hip_atomic_load(p, __ATOMIC_RELAXED, __HIP_MEMORY_SCOPE_AGENT); }
__device__ __forceinline__ unsigned xb_add(unsigned* p, unsigned v) { return __hip_atomic_fetch_add(p, v, __ATOMIC_RELAXED, __HIP_MEMORY_SCOPE_AGENT); }
__device__ __forceinline__ unsigned xb_xcc_id() { return (unsigned)__builtin_amdgcn_s_getreg((3 << 11) | 20) & 0xFu; }
#define XB_SPIN(cond, bar) do { unsigned _sp = 0; while (cond) { __builtin_amdgcn_s_sleep(1); \
    if ((++_sp & 255u) == 0u) { if (xb_ld(&(bar)[XB_TMO])) break; if (_sp > XB_SPIN_CAP) { atomicAdd(&(bar)[XB_TMO], 1u); break; } } } } while (0)
struct XcdBarrier { unsigned* bar; unsigned x; volatile LAS unsigned* st; };
__device__ __forceinline__ XcdBarrier xcd_barrier_post(unsigned* bar, volatile LAS unsigned* st) {
    XcdBarrier b; b.bar = bar; b.x = xb_xcc_id(); b.st = st;
    if (threadIdx.x == 0) (void)xb_add(&bar[XB_XCNT(b.x)], 1u);
    return b;
}
__device__ __forceinline__ void xcd_barrier_complete(unsigned* bar, unsigned x, unsigned& nloc, unsigned& nx) {
    const unsigned G = gridDim.x * gridDim.y * gridDim.z;
    unsigned sum, cnt, mine, sp = 0u;
    for (;;) {
        sum = 0u; cnt = 0u; mine = 0u;
#pragma unroll
        for (unsigned j = 0; j < 16; ++j) { const unsigned c = xb_ld(&bar[XB_XCNT(j)]); sum += c; cnt += (c > 0u) ? 1u : 0u; mine = (j == x) ? c : mine; }
        if (sum == G) break;
        __builtin_amdgcn_s_sleep(1);
        if ((++sp & 255u) == 0u) { if (xb_ld(&bar[XB_TMO])) break; if (sp > XB_SPIN_CAP) { atomicAdd(&bar[XB_TMO], 1u); break; } }
    }
    nloc = mine > 0u ? mine : 1u; nx = cnt > 0u ? cnt : 1u;
}
__device__ __forceinline__ void xcd_barrier(const XcdBarrier& b) {
    asm volatile("s_waitcnt vmcnt(0)" ::: "memory");
    __syncthreads();
    if (threadIdx.x == 0) {
        unsigned* bar = b.bar;
        __builtin_amdgcn_s_waitcnt(0);
        unsigned nloc = b.st[0], nx = b.st[1];
        if (nloc == 0u) { xcd_barrier_complete(bar, b.x, nloc, nx); b.st[0] = nloc; b.st[1] = nx; }
        const unsigned old = xb_add(&bar[XB_XSUB(b.x)], 1u);
        const unsigned gen = old / nloc;
        if (old + 1u == (gen + 1u) * nloc) {
            __builtin_amdgcn_fence(__ATOMIC_RELEASE, "agent");
            asm volatile("s_waitcnt vmcnt(0)" ::: "memory");
            const unsigned og = xb_add(&bar[XB_TOP], 1u);
            const unsigned tg = og / nx;
            if (og + 1u == (tg + 1u) * nx) xb_add(&bar[XB_TOPGEN], 1u);
            else XB_SPIN(xb_ld(&bar[XB_TOPGEN]) == tg, bar);
            __builtin_amdgcn_fence(__ATOMIC_ACQUIRE, "agent");
            xb_add(&bar[XB_XGEN(b.x)], 1u);
            asm volatile("s_waitcnt vmcnt(0)" ::: "memory");
        } else {
            XB_SPIN(xb_ld(&bar[XB_XGEN(b.x)]) == gen, bar);
            __builtin_amdgcn_fence(__ATOMIC_ACQUIRE, "agent");
            asm volatile("s_waitcnt vmcnt(0)" ::: "memory");
        }
    }
    __syncthreads();
}

namespace pg8 {
#define PG8_LAS __attribute__((address_space(3)))
typedef unsigned short bf16_t;
typedef short bf16x8 __attribute__((ext_vector_type(8)));
typedef float f32x4 __attribute__((ext_vector_type(4)));
typedef unsigned u32x4 __attribute__((ext_vector_type(4)));
constexpr int BM = 256, BK = 64, HALF = 128, HTB = HALF * BK * 2  , STAGE_BYTES = 8 * HTB, NXCD = 8, WGM = 8;

__host__ __device__ __forceinline__ int lds_byte(int r, int c) { const int st = (r >> 4) * 2 + (c >> 5), rr = r & 15, cc = c & 31, ob = rr * 64 + cc * 2; return st * 1024 + (ob ^ (((ob >> 9) & 1) << 5)); }
__host__ __device__ __forceinline__ void stage_rc(int b, int& R, int& C) { const int st = b / 1024, sb = b % 1024, swz = sb ^ (((sb >> 9) & 1) << 5); R = (st >> 1) * 16 + swz / 64; C = (st & 1) * 32 + (swz % 64) / 2; }
__host__ __device__ __forceinline__ int perm32(int rho) { const int n = rho >> 4, i = rho & 15; return 8 * (i >> 2) + 4 * n + (i & 3); }

struct Unit { int pm, pn; };
struct Gemm { const bf16_t* A; const bf16_t* Bt; int M, N, K; };

struct StaticOrder {
    int nM, nN, nwg, G, c;
    __host__ __device__ void init(int M, int N, int G_, int c_) { nM = M / BM; nN = N / BM; nwg = nM * nN; G = G_; c = c_; }
    __host__ __device__ bool next(int i, Unit& u) const {
        const long L = (long)i * G + c; if (L >= nwg) return false;
        int wgid = (int)L; { const int q = nwg / NXCD, r = nwg % NXCD, xcd = wgid % NXCD, off = wgid / NXCD; wgid = (xcd < r ? xcd * (q + 1) : r * (q + 1) + (xcd - r) * q) + off; }
        const int nig = WGM * nN, gid = wgid / nig, fm = gid * WGM, gsz = (nM - fm) < WGM ? (nM - fm) : WGM;
        u.pm = fm + ((wgid % nig) % gsz); u.pn = (wgid % nig) / gsz; return true;
    }
    __device__ __forceinline__ void a_ready(const Unit&) const {}
    __device__ __forceinline__ void done(const Unit&) const {}
};

__device__ __forceinline__ unsigned cvt_pk_bf16(float lo, float hi) { unsigned r; asm volatile("v_cvt_pk_bf16_f32 %0, %1, %2" : "=v"(r) : "v"(lo), "v"(hi)); return r; }
template <int ACT  > struct EpiBf16 {
    static constexpr bool PERM = true, AFTER_DRAIN = false; static_assert(ACT == 0, "EpiBf16: ACT is 0 (none)");
    bf16_t* O; int ldc; const float* bias; int split_cols; size_t split_stride; float scale0;
    __device__ __forceinline__ void operator()(const f32x4 (&acc)[2][2][4][2], const Unit& u, int wr, int wc, int fr, int fq) const {
        const int row0 = u.pm * BM + wr * 64 + fr; int colt = u.pn * BM; bf16_t* base = O;
        float sc = 1.f; if (split_cols) { const int t = colt / split_cols; base += (size_t)t * split_stride; colt -= t * split_cols; if (t == 0) sc = scale0; }
        const int col0 = colt + wc * 32 + 8 * fq, bcol0 = u.pn * BM + wc * 32 + 8 * fq;
        f32x4 bv[2][2];
#pragma unroll
        for (int bj = 0; bj < 2; ++bj)
#pragma unroll
            for (int n = 0; n < 2; ++n) bv[bj][n] = bias ? *(const f32x4*)(bias + bcol0 + bj * HALF + 4 * n) : (f32x4){0.f, 0.f, 0.f, 0.f};
#pragma unroll
        for (int ai = 0; ai < 2; ++ai)
#pragma unroll
            for (int m = 0; m < 4; ++m) { bf16_t* rowp = base + (size_t)(row0 + ai * HALF + m * 16) * ldc + col0;
#pragma unroll
                for (int bj = 0; bj < 2; ++bj) { f32x4 v0 = acc[ai][bj][m][0] + bv[bj][0], v1 = acc[ai][bj][m][1] + bv[bj][1];
                    v0 = v0 * sc; v1 = v1 * sc; u32x4 w; w.x = cvt_pk_bf16(v0[0], v0[1]); w.y = cvt_pk_bf16(v0[2], v0[3]); w.z = cvt_pk_bf16(v1[0], v1[1]); w.w = cvt_pk_bf16(v1[2], v1[3]);
                    *(u32x4*)(rowp + bj * HALF) = w; } }
    }
};

struct EpiF32 {
    static constexpr bool PERM = false, AFTER_DRAIN = false;
    float* C; int ldc;
    __device__ __forceinline__ void operator()(const f32x4 (&acc)[2][2][4][2], const Unit& u, int wr, int wc, int fr, int fq) const {
        const int row0 = u.pm * BM + wr * 64 + fr, col0 = u.pn * BM + wc * 32 + 4 * fq;
#pragma unroll
        for (int ai = 0; ai < 2; ++ai)
#pragma unroll
            for (int m = 0; m < 4; ++m) { float* rowp = C + (size_t)(row0 + ai * HALF + m * 16) * ldc + col0;
#pragma unroll
                for (int bj = 0; bj < 2; ++bj)
#pragma unroll
                    for (int n = 0; n < 2; ++n) *(f32x4*)(rowp + bj * HALF + n * 16) = acc[ai][bj][m][n]; }
    }
};
struct EpiGU {
    static constexpr bool PERM = true, AFTER_DRAIN = false;
    bf16_t* O; int ldc;
    __device__ __forceinline__ void operator()(const f32x4 (&acc)[2][2][4][2], const Unit& u, int wr, int wc, int fr, int fq) const {
        const int row0 = u.pm * BM + wr * 64 + fr, col0 = u.pn * HALF + wc * 32 + 8 * fq;
#pragma unroll
        for (int ai = 0; ai < 2; ++ai)
#pragma unroll
            for (int m = 0; m < 4; ++m) { bf16_t* rowp = O + (size_t)(row0 + ai * HALF + m * 16) * ldc + col0;
                f32x4 h0, h1;
#pragma unroll
                for (int r = 0; r < 4; ++r) { const float g0 = acc[ai][0][m][0][r], g1 = acc[ai][0][m][1][r];
                    h0[r] = g0 * __builtin_amdgcn_rcpf(1.0f + __expf(-g0)) * acc[ai][1][m][0][r]; h1[r] = g1 * __builtin_amdgcn_rcpf(1.0f + __expf(-g1)) * acc[ai][1][m][1][r]; }
                u32x4 w; w.x = cvt_pk_bf16(h0[0], h0[1]); w.y = cvt_pk_bf16(h0[2], h0[3]); w.z = cvt_pk_bf16(h1[0], h1[1]); w.w = cvt_pk_bf16(h1[2], h1[3]);
                *(u32x4*)rowp = w; }
    }
};

template <class Epi, class Sched, bool ALIGN_EPI = false, bool SP2 = false>
__device__ __forceinline__ void gemm_phase(PG8_LAS unsigned char* lds, const Gemm g, const Sched& S, const Epi& E) {
    const int tid = threadIdx.x, wid = __builtin_amdgcn_readfirstlane(tid >> 6), lane = tid & 63, wr = wid >> 2, wc = wid & 3, fr = lane & 15, fq = lane >> 4;
    const int K = g.K, nt = K / BK;
    unsigned voffA[2], voffB[2];
#pragma unroll
    for (int i = 0; i < 2; ++i) { int R, C; stage_rc(tid * 16 + i * 8192, R, C); const int Rb = Epi::PERM ? ((R & ~31) + perm32(R & 31)) : R;
        voffA[i] = (unsigned)(R * K + C) * 2u; voffB[i] = (unsigned)(Rb * K + C) * 2u; }
    const size_t kstep = (size_t)(BK * 2);
    const size_t hstep = (size_t)HALF * K * 2;
    const size_t tstep = 2 * hstep;
    const unsigned ldsw = (unsigned)wid * 1024u;
    const int aoff = lds_byte(wr * 64 + fr, fq * 8), boff = lds_byte(wc * 32 + fr, fq * 8);
#define PG8_SA(b, h) (((b) * 2 + (h)) * HTB)
#define PG8_SB(b, h) ((4 + (b) * 2 + (h)) * HTB)
#define PG8_STAGE(bufoff, gbase, voff) do { _Pragma("unroll") for (int _i = 0; _i < 2; ++_i) \
        __builtin_amdgcn_global_load_lds((const unsigned*)((const char*)(gbase) + (voff)[_i]), (PG8_LAS unsigned*)(lds + (bufoff) + ldsw + _i * 8192), 16, 0, 0); } while (0)
#define PG8_LDA(dst, b, h) do { _Pragma("unroll") for (int m = 0; m < 4; ++m) _Pragma("unroll") for (int k = 0; k < 2; ++k) dst[m][k] = *(const PG8_LAS bf16x8*)(lds + PG8_SA(b, h) + aoff + m * 2048 + k * 1024); } while (0)
#define PG8_LDB(dst, b, h) do { _Pragma("unroll") for (int n = 0; n < 2; ++n) _Pragma("unroll") for (int k = 0; k < 2; ++k) dst[n][k] = *(const PG8_LAS bf16x8*)(lds + PG8_SB(b, h) + boff + n * 2048 + k * 1024); } while (0)
#define PG8_MMA(ai, bj, At, Bt) do { __builtin_amdgcn_s_setprio(1); _Pragma("unroll") for (int m = 0; m < 4; ++m) _Pragma("unroll") for (int n = 0; n < 2; ++n) _Pragma("unroll") for (int k = 0; k < 2; ++k) \
        acc[ai][bj][m][n] = __builtin_amdgcn_mfma_f32_16x16x32_bf16(Bt[n][k], At[m][k], acc[ai][bj][m][n], 0, 0, 0); __builtin_amdgcn_s_setprio(0); } while (0)
#define PG8_WAIT_V(n) asm volatile("s_waitcnt vmcnt(" #n ")" ::: "memory")
#define PG8_WAIT_L(n) asm volatile("s_waitcnt lgkmcnt(" #n ")" ::: "memory")
#define PG8_BAR __builtin_amdgcn_s_barrier()
#define PG8_SCHED __builtin_amdgcn_sched_barrier(0)
    Unit cur, nxt; int ui = 0;
    if (!S.next(0, cur)) return;
    f32x4 acc[2][2][4][2];
#pragma unroll
    for (int a = 0; a < 2; ++a)
#pragma unroll
        for (int b = 0; b < 2; ++b)
#pragma unroll
            for (int m = 0; m < 4; ++m)
#pragma unroll
                for (int n = 0; n < 2; ++n) acc[a][b][m][n] = (f32x4){0.f, 0.f, 0.f, 0.f};
    bf16x8 At[4][2], B0[2][2], B1[2][2];
    const char* cA = (const char*)g.A + (size_t)cur.pm * tstep; const char* cB = (const char*)g.Bt + (size_t)cur.pn * tstep;
    S.a_ready(cur);
    if constexpr (SP2) {
        PG8_STAGE(PG8_SB(0, 0), cB, voffB); PG8_STAGE(PG8_SB(0, 1), cB + hstep, voffB); PG8_STAGE(PG8_SA(0, 0), cA, voffA); PG8_STAGE(PG8_SA(0, 1), cA + hstep, voffA);
        if (wr == 1) PG8_BAR;
        PG8_WAIT_V(2); PG8_BAR;
        PG8_STAGE(PG8_SB(1, 0), cB + kstep, voffB); PG8_STAGE(PG8_SA(1, 0), cA + kstep, voffA); PG8_STAGE(PG8_SB(1, 1), cB + hstep + kstep, voffB);
        PG8_WAIT_V(6); PG8_BAR;
    } else {
        PG8_STAGE(PG8_SB(0, 0), cB, voffB); PG8_STAGE(PG8_SA(0, 0), cA, voffA); PG8_STAGE(PG8_SB(0, 1), cB + hstep, voffB); PG8_STAGE(PG8_SA(0, 1), cA + hstep, voffA);
        if (wr == 1) PG8_BAR;
        PG8_WAIT_V(4); PG8_BAR;
        PG8_STAGE(PG8_SB(1, 0), cB + kstep, voffB); PG8_STAGE(PG8_SA(1, 0), cA + kstep, voffA); PG8_STAGE(PG8_SB(1, 1), cB + hstep + kstep, voffB);
        PG8_WAIT_V(6); PG8_BAR;
    }
    for (;;) {
        const bool has_next = S.next(ui + 1, nxt);
        const char* nA = has_next ? (const char*)g.A + (size_t)nxt.pm * tstep : cA; const char* nB = has_next ? (const char*)g.Bt + (size_t)nxt.pn * tstep : cB;
        for (int t = 0; t < nt; t += 2) {
            const bool last = (t == nt - 2);
            const char* a1 = cA + (size_t)(t + 1) * kstep;
            const char* a2 = last ? nA : cA + (size_t)(t + 2) * kstep; const char* b2 = last ? nB : cB + (size_t)(t + 2) * kstep;
            const char* a3 = a2 + kstep; const char* b3 = b2 + kstep;
            if (last && has_next) S.a_ready(nxt);
            if constexpr (SP2) {
            PG8_LDB(B0, 0, 0); PG8_LDB(B1, 0, 1); PG8_SCHED; PG8_LDA(At, 0, 0); PG8_STAGE(PG8_SA(1, 1), a1 + hstep, voffA);
            PG8_WAIT_V(8); PG8_WAIT_L(0); PG8_BAR; PG8_MMA(0, 0, At, B0); PG8_MMA(0, 1, At, B1); PG8_BAR; PG8_SCHED;
            PG8_LDA(At, 0, 1); PG8_STAGE(PG8_SB(0, 0), b2, voffB); PG8_STAGE(PG8_SB(0, 1), b2 + hstep, voffB); PG8_STAGE(PG8_SA(0, 0), a2, voffA);
            PG8_WAIT_V(8); PG8_WAIT_L(0); PG8_BAR; PG8_MMA(1, 0, At, B0); PG8_MMA(1, 1, At, B1); PG8_BAR; PG8_SCHED;
            PG8_LDB(B0, 1, 0); PG8_LDB(B1, 1, 1); PG8_SCHED; PG8_LDA(At, 1, 0); PG8_STAGE(PG8_SA(0, 1), a2 + hstep, voffA);
            PG8_WAIT_V(8); PG8_WAIT_L(0); PG8_BAR; PG8_MMA(0, 0, At, B0); PG8_MMA(0, 1, At, B1); PG8_BAR; PG8_SCHED;
            PG8_LDA(At, 1, 1); PG8_STAGE(PG8_SB(1, 0), b3, voffB); PG8_STAGE(PG8_SB(1, 1), b3 + hstep, voffB); PG8_STAGE(PG8_SA(1, 0), a3, voffA);
            PG8_WAIT_V(8); PG8_WAIT_L(0); PG8_BAR; PG8_MMA(1, 0, At, B0); PG8_MMA(1, 1, At, B1); PG8_BAR; PG8_SCHED;
            } else {
            PG8_LDB(B0, 0, 0); PG8_SCHED; PG8_LDA(At, 0, 0); PG8_STAGE(PG8_SA(1, 1), a1 + hstep, voffA);
            PG8_WAIT_L(8); PG8_BAR; PG8_WAIT_L(0); PG8_MMA(0, 0, At, B0); PG8_BAR; PG8_SCHED;
            PG8_LDB(B1, 0, 1); PG8_STAGE(PG8_SB(0, 0), b2, voffB);
            PG8_BAR; PG8_WAIT_L(0); PG8_MMA(0, 1, At, B1); PG8_BAR;
            PG8_LDA(At, 0, 1); PG8_STAGE(PG8_SA(0, 0), a2, voffA);
            PG8_BAR; PG8_WAIT_L(0); PG8_MMA(1, 0, At, B0); PG8_BAR; PG8_SCHED;
            PG8_STAGE(PG8_SB(0, 1), b2 + hstep, voffB);
            PG8_WAIT_V(6); PG8_BAR; PG8_MMA(1, 1, At, B1); PG8_BAR;
            PG8_LDB(B0, 1, 0); PG8_SCHED; PG8_LDA(At, 1, 0); PG8_STAGE(PG8_SA(0, 1), a2 + hstep, voffA);
            PG8_WAIT_L(8); PG8_BAR; PG8_WAIT_L(0); PG8_MMA(0, 0, At, B0); PG8_BAR; PG8_SCHED;
            PG8_LDB(B1, 1, 1); PG8_STAGE(PG8_SB(1, 0), b3, voffB);
            PG8_BAR; PG8_WAIT_L(0); PG8_MMA(0, 1, At, B1); PG8_BAR;
            PG8_LDA(At, 1, 1); PG8_STAGE(PG8_SA(1, 0), a3, voffA);
            PG8_BAR; PG8_WAIT_L(0); PG8_MMA(1, 0, At, B0); PG8_BAR; PG8_SCHED;
            PG8_STAGE(PG8_SB(1, 1), b3 + hstep, voffB);
            PG8_WAIT_V(6); PG8_BAR; PG8_MMA(1, 1, At, B1); PG8_BAR;
            }
        }
        if constexpr (ALIGN_EPI) { if (wr == 0) PG8_BAR; }
        if constexpr (!Epi::AFTER_DRAIN) { E(acc, cur, wr, wc, fr, fq); S.done(cur); }
        if (!has_next) break;
#pragma unroll
        for (int a = 0; a < 2; ++a)
#pragma unroll
            for (int b = 0; b < 2; ++b)
#pragma unroll
                for (int m = 0; m < 4; ++m)
#pragma unroll
                    for (int n = 0; n < 2; ++n) acc[a][b][m][n] = (f32x4){0.f, 0.f, 0.f, 0.f};
        cur = nxt; cA = nA; cB = nB; ++ui;
        if constexpr (ALIGN_EPI) { if (wr == 1) PG8_BAR; }
    }
    PG8_WAIT_V(0);
    if constexpr (!ALIGN_EPI) { if (wr == 0) PG8_BAR; }
    PG8_BAR;
    if constexpr (Epi::AFTER_DRAIN) { E.fused(acc, cur, wr, wc, fr, fq, lds, wid, lane); S.done(cur); }
#undef PG8_SA
#undef PG8_SB
#undef PG8_STAGE
#undef PG8_LDA
#undef PG8_LDB
#undef PG8_MMA
#undef PG8_WAIT_V
#undef PG8_WAIT_L
#undef PG8_BAR
#undef PG8_SCHED
}
}


struct Ctx { LAS unsigned char* lds; int tid, lane, wave, G, gw, NGW; };

template <bool GU>
__device__ __forceinline__ void transpose_item(const float* __restrict__ W, int K, int N, bf16_t* __restrict__ WT, LAS float* scr, int item, int lane) {
    const int nblk = N / 32, kb = item / nblk, nb = item % nblk, k0 = 64 * kb, n0 = 32 * nb;
#pragma unroll 8
    for (int i = 0; i < 32; ++i) { const int kk = 2 * i + (lane >> 5); scr[kk * 33 + (lane & 31)] = W[(size_t)(k0 + kk) * N + n0 + (lane & 31)]; }
    asm volatile("s_waitcnt lgkmcnt(0)" ::: "memory");
    const int c = lane & 7;
#pragma unroll
    for (int j = 0; j < 4; ++j) { const int n = (lane >> 3) + 8 * j; const LAS float* s = scr + (8 * c) * 33 + n;
        v4u o; o.x = pk2(s[0 * 33], s[1 * 33]); o.y = pk2(s[2 * 33], s[3 * 33]); o.z = pk2(s[4 * 33], s[5 * 33]); o.w = pk2(s[6 * 33], s[7 * 33]);
        const int nn = n0 + n, orow = GU ? (nn < FH ? (nn >> 7) * 256 + (nn & 127) : ((nn - FH) >> 7) * 256 + 128 + ((nn - FH) & 127)) : nn;
        *(v4u*)(WT + (size_t)orow * K + k0 + 8 * c) = o; }
    asm volatile("s_waitcnt lgkmcnt(0)" ::: "memory");
}
__device__ __forceinline__ void embed_row(const float* __restrict__ xp, const float* __restrict__ xs, const float* __restrict__ meta, bf16_t* __restrict__ Hb, int row, int lane) {
    const float* src = nullptr;
    if (row < MP_PROMPT) { const int b = row / TPP, p = row % TPP; if (p >= PADF) { const int i = p - PADF; src = i < NMETA ? meta + (size_t)i * D : xp + ((size_t)b * SEQ + (i - NMETA)) * D; } }
    else src = xs + (size_t)(row - MP_PROMPT) * D;
    v2u* o = (v2u*)(Hb + (size_t)row * D) + lane;
#pragma unroll
    for (int j = 0; j < 4; ++j) { v2u w = {0u, 0u}; if (src) { const f32x4 v = ((const f32x4*)src)[lane + 64 * j]; w.x = pk2(v[0], v[1]); w.y = pk2(v[2], v[3]); } o[64 * j] = w; }
}
__device__ __forceinline__ void phase_prologue(const Ctx& c, const float* const* in, unsigned char* ws) {
    LAS float* scr = (LAS float*)(c.lds + c.wave * 16384);
    constexpr int I_ABI = 16 * (AB_IN / 32), I_O = 16 * 32, I_CDI = 16 * (CD_IN / 32), I_GU = 16 * (2 * FH / 32), I_DN = (FH / 64) * 32;
    constexpr int NITEMS = I_ABI + I_O + I_CDI + I_O + 2 * I_GU + 2 * I_DN;
    for (int it = c.gw; it < NITEMS; it += c.NGW) {
        int r = it;
        if (r < I_ABI) { transpose_item<false>(in[8], D, AB_IN, (bf16_t*)(ws + WS_WAB_IN), scr, r, c.lane); continue; } r -= I_ABI;
        if (r < I_O) { transpose_item<false>(in[12], D, D, (bf16_t*)(ws + WS_WAB_O), scr, r, c.lane); continue; } r -= I_O;
        if (r < I_CDI) { transpose_item<false>(in[13], D, CD_IN, (bf16_t*)(ws + WS_WCD_IN), scr, r, c.lane); continue; } r -= I_CDI;
        if (r < I_O) { transpose_item<false>(in[21], D, D, (bf16_t*)(ws + WS_WCD_O), scr, r, c.lane); continue; } r -= I_O;
        if (r < 2 * I_GU) { const int l = r / I_GU; transpose_item<true>(in[26] + (size_t)l * D * 2 * FH, D, 2 * FH, (bf16_t*)(ws + WS_WGU) + (size_t)l * 2 * FH * D, scr, r % I_GU, c.lane); continue; } r -= 2 * I_GU;
        { const int l = r / I_DN; transpose_item<false>(in[27] + (size_t)l * FH * D, FH, D, (bf16_t*)(ws + WS_WDN) + (size_t)l * D * FH, scr, r % I_DN, c.lane); }
    }
    for (int row = c.gw; row < MP; row += c.NGW) embed_row(in[0], in[1], in[7], (bf16_t*)(ws + WS_HB), row, c.lane);
    if (blockIdx.x == 0) { const int ch = c.tid; const float l0 = in[19][ch], l1 = in[19][512 + ch]; const float m = fmaxf(l0, l1); const float e0 = expf(l0 - m), e1 = expf(l1 - m); ((float*)(ws + WS_LB))[ch] = e1 / (e0 + e1); }
}

__device__ __forceinline__ void phase_ln_residual(const Ctx& c, bf16_t* __restrict__ Hb, const float* __restrict__ mix, const float* __restrict__ g, const float* __restrict__ b, float* __restrict__ outf) {
    for (int row = c.gw; row < MP; row += c.NGW) {
        f32x4 y[4]; float s = 0.f;
        const v2u* hp = (const v2u*)(Hb + (size_t)row * D) + c.lane; const f32x4* mp = (const f32x4*)(mix + (size_t)row * D) + c.lane;
#pragma unroll
        for (int j = 0; j < 4; ++j) { const v2u hw = hp[64 * j]; const f32x4 mv = mp[64 * j];
            y[j][0] = ALPHA * __uint_as_float(hw.x << 16) + mv[0]; y[j][1] = ALPHA * __uint_as_float(hw.x & 0xffff0000u) + mv[1];
            y[j][2] = ALPHA * __uint_as_float(hw.y << 16) + mv[2]; y[j][3] = ALPHA * __uint_as_float(hw.y & 0xffff0000u) + mv[3];
            s += (y[j][0] + y[j][1]) + (y[j][2] + y[j][3]); }
        const float mu = wave_sum(s) * (1.0f / D); float q = 0.f;
#pragma unroll
        for (int j = 0; j < 4; ++j) { y[j] = y[j] - mu; q += (y[j][0] * y[j][0] + y[j][1] * y[j][1]) + (y[j][2] * y[j][2] + y[j][3] * y[j][3]); }
        const float rstd = rsqrtf(wave_sum(q) * (1.0f / D) + 1e-5f);
        float* op = nullptr;
        if (outf) { if (row < MP_PROMPT) { const int bb = row / TPP, p = row % TPP; if (p >= PADF + NMETA) op = outf + O_YP + ((size_t)bb * SEQ + (p - PADF - NMETA)) * D; } else op = outf + O_YS + (size_t)(row - MP_PROMPT) * D; }
        v2u* ho = (v2u*)(Hb + (size_t)row * D) + c.lane;
#pragma unroll
        for (int j = 0; j < 4; ++j) { const f32x4 gv = ((const f32x4*)g)[c.lane + 64 * j], bv = ((const f32x4*)b)[c.lane + 64 * j]; const f32x4 v = y[j] * rstd * gv + bv;
            v2u w; w.x = pk2(v[0], v[1]); w.y = pk2(v[2], v[3]); ho[64 * j] = w; if (op) ((f32x4*)op)[c.lane + 64 * j] = v; }
    }
}

__device__ __forceinline__ void phase_attn(const Ctx& c, const bf16_t* __restrict__ P0, const float* __restrict__ ck, const float* __restrict__ cv, const float* __restrict__ sinks, bf16_t* __restrict__ MIX) {
    LAS bf16_t* Ks = (LAS bf16_t*)c.lds;
    LAS bf16_t* Vs = Ks + 2 * 192 * 64;
    const int tid = c.tid;
    for (int T = blockIdx.x; T < NTILE64; T += c.G) {
        const bool samp = T >= NB * 65; const int s = T - NB * 65, cc = samp ? 0 : T % 65;
        const int row0 = T * 64;
        __syncthreads();
        for (int idx = tid; idx < 2 * 192 * 64; idx += NTHREADS) {
            const int kvh = idx / (192 * 64), rem = idx % (192 * 64), j = rem >> 6, d = rem & 63; bf16_t kv = 0, vv = 0;
            if (samp) { if (j < 128) { kv = f2bf(ck[(((size_t)s * 128 + j) * 2 + kvh) * 64 + d]); vv = f2bf(cv[(((size_t)s * 128 + j) * 2 + kvh) * 64 + d]); }
                        else { const size_t r = (size_t)(row0 + j - 128) * AB_IN; kv = P0[r + 512 + kvh * 64 + d]; vv = P0[r + 640 + kvh * 64 + d]; } }
            else { const int rel = (cc - 2) * 64 + j; if (rel >= PADF) { const size_t r = (size_t)(row0 - 128 + j) * AB_IN; kv = P0[r + 512 + kvh * 64 + d]; vv = P0[r + 640 + kvh * 64 + d]; } }
            Ks[idx] = kv; Vs[idx] = vv;
        }
        __syncthreads();
        const int kvh = tid >> 8, t = (tid & 255) >> 2, g = tid & 3, h = kvh * 4 + g;
        const LAS bf16_t* Kh = Ks + kvh * 192 * 64; const LAS bf16_t* Vh = Vs + kvh * 192 * 64;
        const float slope = exp2f(-(float)(h + 1)), sink = sinks[h];
        float q[64], o[64];
        { const bf16_t* qp = P0 + (size_t)(row0 + t) * AB_IN + h * 64;
#pragma unroll
          for (int d = 0; d < 64; ++d) { q[d] = bf2f(qp[d]) * 0.125f; o[d] = 0.f; } }
        float m = sink, l = 1.0f;
        const int jmin = samp ? 0 : ((cc - 2) * 64 >= PADF ? 0 : PADF - (cc - 2) * 64);
        for (int j = jmin; j < 192; ++j) {
            float sc = 0.f;
#pragma unroll
            for (int d = 0; d < 64; ++d) sc += q[d] * bf2f(Kh[j * 64 + d]);
            sc -= slope * fabsf((float)(128 + t - j));
            const float mn = fmaxf(m, sc), a = __expf(m - mn), p = __expf(sc - mn);
            l = l * a + p; m = mn;
#pragma unroll
            for (int d = 0; d < 64; ++d) o[d] = o[d] * a + p * bf2f(Vh[j * 64 + d]);
        }
        const float inv = 1.0f / l;
        bf16_t* op = MIX + (size_t)(row0 + t) * D + h * 64;
#pragma unroll
        for (int d = 0; d < 64; ++d) op[d] = f2bf(o[d] * inv);
    }
    __syncthreads();
}

__device__ __forceinline__ float convb_u(const bf16_t* __restrict__ P0, const float* __restrict__ stb, int row, int back, int ch) {
    if (row < MP_PROMPT) { const int p = row % TPP - back; if (p < PADF) return 0.f; const size_t r = (size_t)(row - back) * AB_IN; return bf2f(P0[r + 1280 + ch]) * bf2f(P0[r + 1792 + ch]); }
    const int s = (row - MP_PROMPT) / TS, t = (row - MP_PROMPT) % TS - back;
    if (t < 0) return stb[((size_t)s * 2 + (2 + t)) * 512 + ch];
    const size_t r = (size_t)(row - back) * AB_IN; return bf2f(P0[r + 1280 + ch]) * bf2f(P0[r + 1792 + ch]);
}
__device__ __forceinline__ void phase_convb(const Ctx& c, const bf16_t* __restrict__ P0, const float* __restrict__ stb, const float* __restrict__ w, bf16_t* __restrict__ MIX) {
    for (int row = c.gw; row < MP; row += c.NGW)
        for (int ch = c.lane; ch < 512; ch += 64) {
            const float cb = w[ch] * convb_u(P0, stb, row, 2, ch) + w[512 + ch] * convb_u(P0, stb, row, 1, ch) + w[1024 + ch] * convb_u(P0, stb, row, 0, ch);
            MIX[(size_t)row * D + 512 + ch] = f2bf(bf2f(P0[(size_t)row * AB_IN + 768 + ch]) * cb);
        }
}
__device__ __forceinline__ void phase_outs_l0(const Ctx& c, const bf16_t* __restrict__ P0, const float* __restrict__ ck, const float* __restrict__ cv, float* __restrict__ out) {
    for (int gid = blockIdx.x * NTHREADS + c.tid; gid < 131072; gid += c.G * NTHREADS) {
        if (gid < 65536) { const int b = gid >> 14, j = (gid >> 7) & 127, cc = gid & 127; const size_t r = (size_t)(b * TPP + PADF + TP - 128 + j) * AB_IN;
            out[O_KAP + gid] = bf2f(P0[r + 512 + cc]); out[O_VAP + gid] = bf2f(P0[r + 640 + cc]); }
        { const int s = gid >> 14, j = (gid >> 7) & 127, cc = gid & 127;
          if (j < 64) { out[O_KAS + gid] = ck[((size_t)s * 128 + 64 + j) * 128 + cc]; out[O_VAS + gid] = cv[((size_t)s * 128 + 64 + j) * 128 + cc]; }
          else { const size_t r = (size_t)(MP_PROMPT + s * 64 + (j - 64)) * AB_IN; out[O_KAS + gid] = bf2f(P0[r + 512 + cc]); out[O_VAS + gid] = bf2f(P0[r + 640 + cc]); } }
        if (gid < 4096) { const int b = gid >> 10, j = (gid >> 9) & 1, ch = gid & 511; const size_t r = (size_t)(b * TPP + PADF + TP - 2 + j) * AB_IN;
            out[O_CBP + gid] = bf2f(P0[r + 1280 + ch]) * bf2f(P0[r + 1792 + ch]); }
        if (gid < 8192) { const int s = gid >> 10, j = (gid >> 9) & 1, ch = gid & 511; const size_t r = (size_t)(MP_PROMPT + s * 64 + 62 + j) * AB_IN;
            out[O_CBS + gid] = bf2f(P0[r + 1280 + ch]) * bf2f(P0[r + 1792 + ch]); }
    }
}

__device__ __forceinline__ float convc_u(const bf16_t* __restrict__ P1, const float* __restrict__ stc, int row, int back, int ch) {
    if (row < MP_PROMPT) { const int p = row % TPP - back; if (p < PADF) return 0.f; const size_t r = (size_t)(row - back) * CD_IN; return bf2f(P1[r + ch]) * sigmoidf_(bf2f(P1[r + 512 + ch])); }
    const int s = (row - MP_PROMPT) / TS, t = (row - MP_PROMPT) % TS - back;
    if (t < 0) return stc[((size_t)s * 30 + (30 + t)) * 512 + ch];
    const size_t r = (size_t)(row - back) * CD_IN; return bf2f(P1[r + ch]) * sigmoidf_(bf2f(P1[r + 512 + ch]));
}
__device__ __forceinline__ void phase_convc(const Ctx& c, const bf16_t* __restrict__ P1, const float* __restrict__ stc, const float* __restrict__ w, const float* __restrict__ cb, const float* __restrict__ lg, const float* __restrict__ lbv, bf16_t* __restrict__ MIX) {
    for (int row = c.gw; row < MP; row += c.NGW) {
        float v[8]; float s = 0.f;
#pragma unroll
        for (int i = 0; i < 8; ++i) { const int ch = c.lane + 64 * i; float a = cb[ch];
            for (int j = 0; j < 31; ++j) a += w[j * 512 + ch] * convc_u(P1, stc, row, 30 - j, ch);
            v[i] = a; s += a; }
        const float mu = wave_sum(s) * (1.0f / 512.0f); float q = 0.f;
#pragma unroll
        for (int i = 0; i < 8; ++i) { v[i] -= mu; q += v[i] * v[i]; }
        const float rstd = rsqrtf(wave_sum(q) * (1.0f / 512.0f) + 1e-5f);
#pragma unroll
        for (int i = 0; i < 8; ++i) { const int ch = c.lane + 64 * i; MIX[(size_t)row * D + ch] = f2bf(siluf_(v[i] * rstd * lg[ch] + lbv[ch])); }
    }
}
__device__ __forceinline__ void phase_outs_l1(const Ctx& c, const bf16_t* __restrict__ P1, float* __restrict__ out) {
    for (int gid = blockIdx.x * NTHREADS + c.tid; gid < 122880; gid += c.G * NTHREADS) {
        if (gid < 61440) { const int b = gid / 15360, j = (gid / 512) % 30, ch = gid & 511; const size_t r = (size_t)(b * TPP + PADF + TP - 30 + j) * CD_IN;
            out[O_CCP + gid] = bf2f(P1[r + ch]) * sigmoidf_(bf2f(P1[r + 512 + ch])); }
        { const int s = gid / 15360, j = (gid / 512) % 30, ch = gid & 511; const size_t r = (size_t)(MP_PROMPT + s * 64 + 34 + j) * CD_IN;
          out[O_CCS + gid] = bf2f(P1[r + ch]) * sigmoidf_(bf2f(P1[r + 512 + ch])); }
    }
}

constexpr int HG_UNITS = NTILE64 * 4;
constexpr size_t WS_HQ = WS_SPARE, WS_ATT = WS_WGU, WS_DEC = WS_WGU + (size_t)HG_UNITS * 8192;
static_assert((size_t)HG_UNITS * 32768 <= (size_t)MP * 512 * 4 && (size_t)HG_UNITS * (8192 + 512) <= (size_t)2 * FH * D * 2, "hgrn workspace");
__device__ __forceinline__ bf16x8 pack8(f32x4 a, f32x4 b) { v4u w; w.x = pk2(a[0], a[1]); w.y = pk2(a[2], a[3]); w.z = pk2(b[0], b[1]); w.w = pk2(b[2], b[3]); return __builtin_bit_cast(bf16x8, w); }

__device__ __forceinline__ void phase_hgrn_prep(const Ctx& c, const bf16_t* __restrict__ P1, const float* __restrict__ lb, unsigned char* __restrict__ ws) {
    LAS bf16_t* Qs = (LAS bf16_t*)c.lds;
    LAS bf16_t* Ks = Qs + 64 * 136;
    LAS float* segtot = (LAS float*)(Ks + 64 * 136);
    const int tid = c.tid, k = tid & 127, seg = tid >> 7, lane = c.lane, w = c.wave, fr = lane & 15, fq = lane >> 4;
    for (int u = blockIdx.x; u < HG_UNITS; u += c.G) {
        const int T = u >> 2, h = u & 3, row0 = T * 64;
        const int npad = (T < NB * 65 && (T % 65) == 0) ? PADF : 0;
        const float lbv = lb[h * 128 + k];
        float cum[16], qv[16], kv[16];
        float run = 0.f;
#pragma unroll
        for (int i = 0; i < 16; ++i) { const int t = seg * 16 + i; const size_t r = (size_t)(row0 + t) * CD_IN + h * 128 + k;
            const float fg = lbv + (1.0f - lbv) * sigmoidf_(bf2f(P1[r + 1536])); const bool pad = t < npad;
            run += pad ? 0.f : __logf(fg); cum[i] = run; kv[i] = pad ? 0.f : 1.0f - fg; qv[i] = bf2f(P1[r + 1024]); }
        __syncthreads();
        segtot[seg * 128 + k] = run;
        __syncthreads();
        float off = 0.f, tot = 0.f;
#pragma unroll
        for (int s2 = 0; s2 < 4; ++s2) { const float v = segtot[s2 * 128 + k]; off += s2 < seg ? v : 0.f; tot += v; }
        unsigned kdp[8];
#pragma unroll
        for (int i = 0; i < 16; i += 2) {
            const int t = seg * 16 + i; const float c0 = cum[i] + off, c1 = cum[i + 1] + off;
            Qs[t * 136 + k] = f2bf(qv[i] * __expf(c0)); Qs[(t + 1) * 136 + k] = f2bf(qv[i + 1] * __expf(c1));
            Ks[t * 136 + k] = f2bf(kv[i] * __expf(-c0)); Ks[(t + 1) * 136 + k] = f2bf(kv[i + 1] * __expf(-c1));
            kdp[i >> 1] = pk2(kv[i] * __expf(tot - c0), kv[i + 1] * __expf(tot - c1));
        }
        bf16_t* KD = (bf16_t*)(ws + WS_HQ + (size_t)u * 32768 + 16384);
        *(v4u*)(KD + k * 64 + seg * 16) = (v4u){kdp[0], kdp[1], kdp[2], kdp[3]};
        *(v4u*)(KD + k * 64 + seg * 16 + 8) = (v4u){kdp[4], kdp[5], kdp[6], kdp[7]};
        if (seg == 0) ((float*)(ws + WS_DEC))[(size_t)u * 128 + k] = __expf(tot);
        __syncthreads();
        bf16_t* QT = (bf16_t*)(ws + WS_HQ + (size_t)u * 32768);
#pragma unroll
        for (int i = 0; i < 2; ++i) { const int cid = tid + 512 * i, t = cid >> 4, pc = cid & 15, k0 = 32 * (pc >> 2) + 4 * (pc & 3);
            const v2u lo = *(const LAS v2u*)(Qs + t * 136 + k0), hi = *(const LAS v2u*)(Qs + t * 136 + k0 + 16);
            *(v4u*)(QT + t * 128 + pc * 8) = (v4u){lo.x, lo.y, hi.x, hi.y}; }
        const int tt = w >> 1;
        bf16_t* ATT = (bf16_t*)(ws + WS_ATT + (size_t)u * 8192);
#pragma unroll
        for (int si = 0; si < 2; ++si) { const int ss = (w & 1) * 2 + si; f32x4 acc = {0.f, 0.f, 0.f, 0.f};
#pragma unroll
            for (int ks = 0; ks < 4; ++ks) { const bf16x8 a = *(const LAS bf16x8*)(Qs + (16 * tt + fr) * 136 + 32 * ks + 8 * fq), b = *(const LAS bf16x8*)(Ks + (16 * ss + fr) * 136 + 32 * ks + 8 * fq);
                acc = __builtin_amdgcn_mfma_f32_16x16x32_bf16(b, a, acc, 0, 0, 0); }
            const int t = 16 * tt + fr, s0 = 16 * ss + 4 * fq;
            v2u o; o.x = pk2(s0 <= t ? acc[0] : 0.f, s0 + 1 <= t ? acc[1] : 0.f); o.y = pk2(s0 + 2 <= t ? acc[2] : 0.f, s0 + 3 <= t ? acc[3] : 0.f);
            *(v2u*)(ATT + t * 64 + s0) = o; }
    }
    __syncthreads();
}

__device__ __forceinline__ void hgrn_chain(const Ctx& c, int chain, const bf16_t* __restrict__ P1, unsigned char* __restrict__ ws, const float* __restrict__ st_in, const float* __restrict__ ng, bf16_t* __restrict__ MIX, float* __restrict__ out) {
    LAS bf16_t* Qs = (LAS bf16_t*)c.lds;
    LAS bf16_t* KDs = Qs + 64 * 136;
    LAS bf16_t* ATs = KDs + 128 * 72;
    LAS bf16_t* VTs = ATs + 64 * 72;
    LAS float* DECs = (LAS float*)(VTs + 128 * 72);
    LAS float* PART = DECs + 128;
    const int tid = c.tid, lane = c.lane, w = c.wave, fr = lane & 15, fq = lane >> 4;
    const bool samp = chain >= 16; const int seq = samp ? (chain - 16) >> 2 : chain >> 2, h = chain & 3;
    const int nsteps = samp ? 1 : 65, T0 = samp ? NB * 65 + seq : seq * 65;
    f32x4 S[8];
#pragma unroll
    for (int kt = 0; kt < 8; ++kt)
#pragma unroll
        for (int r = 0; r < 4; ++r) S[kt][r] = samp ? st_in[(((size_t)seq * 4 + h) * 128 + 16 * kt + 4 * fq + r) * 128 + 16 * w + fr] : 0.f;
    const float ngv = ng[h * 128 + 16 * w + fr];
    v4u rq[2], rk[2], ra, rv[2]; float rd = 0.f;
#define HG_LOAD(T_) do { const int u_ = (T_) * 4 + h; const bf16_t* QT_ = (const bf16_t*)(ws + WS_HQ + (size_t)u_ * 32768); const bf16_t* KD_ = QT_ + 8192; \
        _Pragma("unroll") for (int i = 0; i < 2; ++i) { const int cid = tid + 512 * i; rq[i] = *(const v4u*)(QT_ + cid * 8); rk[i] = *(const v4u*)(KD_ + cid * 8); \
            rv[i] = *(const v4u*)(P1 + (size_t)((T_) * 64 + (cid >> 4)) * CD_IN + 2048 + h * 128 + (cid & 15) * 8); } \
        ra = *(const v4u*)((const bf16_t*)(ws + WS_ATT + (size_t)u_ * 8192) + tid * 8); \
        if (tid < 128) rd = ((const float*)(ws + WS_DEC))[(size_t)u_ * 128 + tid]; } while (0)
    HG_LOAD(T0);
    for (int n = 0; n < nsteps; ++n) {
        const int T = T0 + n;
        __syncthreads();
#pragma unroll
        for (int i = 0; i < 2; ++i) { const int cid = tid + 512 * i;
            *(LAS v4u*)(Qs + (cid >> 4) * 136 + (cid & 15) * 8) = rq[i];
            *(LAS v4u*)(KDs + (cid >> 3) * 72 + (cid & 7) * 8) = rk[i];
            const int t = cid >> 4, v0 = (cid & 15) * 8;
            VTs[(v0 + 0) * 72 + t] = (bf16_t)(rv[i].x & 0xffffu); VTs[(v0 + 1) * 72 + t] = (bf16_t)(rv[i].x >> 16);
            VTs[(v0 + 2) * 72 + t] = (bf16_t)(rv[i].y & 0xffffu); VTs[(v0 + 3) * 72 + t] = (bf16_t)(rv[i].y >> 16);
            VTs[(v0 + 4) * 72 + t] = (bf16_t)(rv[i].z & 0xffffu); VTs[(v0 + 5) * 72 + t] = (bf16_t)(rv[i].z >> 16);
            VTs[(v0 + 6) * 72 + t] = (bf16_t)(rv[i].w & 0xffffu); VTs[(v0 + 7) * 72 + t] = (bf16_t)(rv[i].w >> 16); }
        *(LAS v4u*)(ATs + (tid >> 3) * 72 + (tid & 7) * 8) = ra;
        if (tid < 128) DECs[tid] = rd;
        __syncthreads();
        if (n + 1 < nsteps) HG_LOAD(T + 1);
        bf16_t gv[16];
#pragma unroll
        for (int tt = 0; tt < 4; ++tt)
#pragma unroll
            for (int r = 0; r < 4; ++r) gv[tt * 4 + r] = P1[(size_t)(T * 64 + 16 * tt + 4 * fq + r) * CD_IN + 2560 + h * 128 + 16 * w + fr];
        bf16x8 bv[2];
#pragma unroll
        for (int s2 = 0; s2 < 2; ++s2) bv[s2] = *(const LAS bf16x8*)(VTs + (16 * w + fr) * 72 + 32 * s2 + 8 * fq);
        f32x4 o[4];
#pragma unroll
        for (int tt = 0; tt < 4; ++tt) o[tt] = (f32x4){0.f, 0.f, 0.f, 0.f};
#pragma unroll
        for (int ks = 0; ks < 4; ++ks) { const bf16x8 sb = pack8(S[2 * ks], S[2 * ks + 1]);
#pragma unroll
            for (int tt = 0; tt < 4; ++tt) { const bf16x8 a = *(const LAS bf16x8*)(Qs + (16 * tt + fr) * 136 + 32 * ks + 8 * fq); o[tt] = __builtin_amdgcn_mfma_f32_16x16x32_bf16(a, sb, o[tt], 0, 0, 0); } }
#pragma unroll
        for (int s2 = 0; s2 < 2; ++s2)
#pragma unroll
            for (int tt = 0; tt < 4; ++tt) { const bf16x8 a = *(const LAS bf16x8*)(ATs + (16 * tt + fr) * 72 + 32 * s2 + 8 * fq); o[tt] = __builtin_amdgcn_mfma_f32_16x16x32_bf16(a, bv[s2], o[tt], 0, 0, 0); }
#pragma unroll
        for (int kt = 0; kt < 8; ++kt) { const f32x4 d = *(const LAS f32x4*)(DECs + 16 * kt + 4 * fq); S[kt] = S[kt] * d;
#pragma unroll
            for (int s2 = 0; s2 < 2; ++s2) { const bf16x8 a = *(const LAS bf16x8*)(KDs + (16 * kt + fr) * 72 + 32 * s2 + 8 * fq); S[kt] = __builtin_amdgcn_mfma_f32_16x16x32_bf16(a, bv[s2], S[kt], 0, 0, 0); } }
#pragma unroll
        for (int tt = 0; tt < 4; ++tt)
#pragma unroll
            for (int r = 0; r < 4; ++r) { float q2 = o[tt][r] * o[tt][r]; q2 += __shfl_xor(q2, 1); q2 += __shfl_xor(q2, 2); q2 += __shfl_xor(q2, 4); q2 += __shfl_xor(q2, 8);
                if (fr == 0) PART[(16 * tt + 4 * fq + r) * 8 + w] = q2; }
        __syncthreads();
#pragma unroll
        for (int tt = 0; tt < 4; ++tt)
#pragma unroll
            for (int r = 0; r < 4; ++r) { const int t = 16 * tt + 4 * fq + r; const f32x4 p0 = *(const LAS f32x4*)(PART + t * 8), p1 = *(const LAS f32x4*)(PART + t * 8 + 4);
                const float ssum = ((p0[0] + p0[1]) + (p0[2] + p0[3])) + ((p1[0] + p1[1]) + (p1[2] + p1[3]));
                const float val = o[tt][r] * rsqrtf(ssum * (1.0f / 128.0f) + 1e-6f) * ngv * siluf_(bf2f(gv[tt * 4 + r]));
                MIX[(size_t)(T * 64 + t) * D + 512 + h * 128 + 16 * w + fr] = f2bf(val); }
    }
#undef HG_LOAD
    float* op = out + (samp ? O_HGS : O_HGP) + ((size_t)seq * 4 + h) * 16384 + 16 * w + fr;
#pragma unroll
    for (int kt = 0; kt < 8; ++kt)
#pragma unroll
        for (int r = 0; r < 4; ++r) op[(size_t)(16 * kt + 4 * fq + r) * 128] = S[kt][r];
    __syncthreads();
}

template <int L>
__device__ __forceinline__ void layer_tail(const Ctx& c, const XcdBarrier& bar, const float* const* in, unsigned char* ws, float* out) {
    bf16_t* Hb = (bf16_t*)(ws + WS_HB); bf16_t* P = (bf16_t*)(ws + WS_P); bf16_t* MIX = (bf16_t*)(ws + WS_MIX);
    float* TMP1 = (float*)(ws + WS_P); float* TMP2 = (float*)(ws + WS_MIX);
    { pg8::Gemm g{MIX, (const bf16_t*)(ws + (L == 0 ? WS_WAB_O : WS_WCD_O)), MP, D, D}; pg8::StaticOrder S; S.init(MP, D, c.G, (int)blockIdx.x); pg8::EpiF32 E{TMP1, D};
      pg8::gemm_phase<pg8::EpiF32, pg8::StaticOrder, true, true>(c.lds, g, S, E); }
    xcd_barrier(bar);
    { int t_ = threadIdx.x; asm volatile("" : "+v"(t_)); Ctx cc = c; cc.tid = t_; cc.lane = t_ & 63; phase_ln_residual(cc, Hb, TMP1, in[22] + L * D, in[23] + L * D, nullptr); }
    xcd_barrier(bar);
    const bf16_t* Wg = (const bf16_t*)(ws + WS_WGU) + (size_t)L * 2 * FH * D;
    { pg8::Gemm g{Hb, Wg, MP, 2 * FH, D}; pg8::StaticOrder S; S.init(MP, 2 * FH, c.G, (int)blockIdx.x); pg8::EpiGU E{P, FH};
      pg8::gemm_phase<pg8::EpiGU, pg8::StaticOrder, true, true>(c.lds, g, S, E); }
    xcd_barrier(bar);
    { pg8::Gemm g{P, (const bf16_t*)(ws + WS_WDN) + (size_t)L * D * FH, MP, D, FH}; pg8::StaticOrder S; S.init(MP, D, c.G, (int)blockIdx.x); pg8::EpiF32 E{TMP2, D};
      pg8::gemm_phase<pg8::EpiF32, pg8::StaticOrder, true, true>(c.lds, g, S, E); }
    xcd_barrier(bar);
    { int t_ = threadIdx.x; asm volatile("" : "+v"(t_)); Ctx cc = c; cc.tid = t_; cc.lane = t_ & 63; phase_ln_residual(cc, Hb, TMP2, in[24] + L * D, in[25] + L * D, L == 1 ? out : nullptr); }
}

struct Params { const float* in[28]; float* out; unsigned char* ws; };
__global__ void __launch_bounds__(NTHREADS) fwd_megakernel(Params p) {
    extern __shared__ __attribute__((aligned(16))) unsigned char lds_raw[];
#define FRESH_CTX(c) Ctx c; { int t_ = threadIdx.x; asm volatile("" : "+v"(t_)); c.lds = (LAS unsigned char*)lds_raw; c.tid = t_; c.lane = t_ & 63; c.wave = __builtin_amdgcn_readfirstlane(t_ >> 6); \
        c.G = gridDim.x; c.gw = blockIdx.x * NWAVES + c.wave; c.NGW = c.G * NWAVES; }
    FRESH_CTX(c);
    volatile LAS unsigned* ctl = (volatile LAS unsigned*)(c.lds + LDSCTL_OFF);
    if (c.tid < 64) ctl[c.tid] = 0u;
    __syncthreads();
    unsigned char* ws = p.ws; const float* const* in = p.in; float* out = p.out;
    XcdBarrier bar = xcd_barrier_post((unsigned*)(ws + WS_CTL) + CW_BAR, ctl + 8);
#define GRID_BAR() xcd_barrier(bar)
    bf16_t* Hb = (bf16_t*)(ws + WS_HB); bf16_t* P = (bf16_t*)(ws + WS_P); bf16_t* MIX = (bf16_t*)(ws + WS_MIX);
    const float* lb = (const float*)(ws + WS_LB);

    phase_prologue(c, in, ws);
    GRID_BAR();
    { pg8::Gemm g{Hb, (const bf16_t*)(ws + WS_WAB_IN), MP, AB_IN, D}; pg8::StaticOrder S; S.init(MP, AB_IN, c.G, (int)blockIdx.x); pg8::EpiBf16<0> E{P, AB_IN, in[9], 0, 0, 1.f};
      pg8::gemm_phase<pg8::EpiBf16<0>, pg8::StaticOrder, true, true>(c.lds, g, S, E); }
    GRID_BAR();
    { FRESH_CTX(cc); phase_attn(cc, P, in[2], in[3], in[10], MIX); }
    { FRESH_CTX(cc); phase_convb(cc, P, in[4], in[11], MIX); }
    { FRESH_CTX(cc); phase_outs_l0(cc, P, in[2], in[3], out); }
    GRID_BAR();
    layer_tail<0>(c, bar, in, ws, out);
    GRID_BAR();
    { pg8::Gemm g{Hb, (const bf16_t*)(ws + WS_WCD_IN), MP, CD_IN, D}; pg8::StaticOrder S; S.init(MP, CD_IN, c.G, (int)blockIdx.x); pg8::EpiBf16<0> E{P, CD_IN, in[14], 0, 0, 1.f};
      pg8::gemm_phase<pg8::EpiBf16<0>, pg8::StaticOrder, true, true>(c.lds, g, S, E); }
    GRID_BAR();
    { FRESH_CTX(cc); phase_hgrn_prep(cc, P, lb, ws); }
    GRID_BAR();
    if (blockIdx.x < 48) { FRESH_CTX(cc); hgrn_chain(cc, (int)blockIdx.x, P, ws, in[6], in[20], MIX, out); }
    { FRESH_CTX(cc); phase_convc(cc, P, in[5], in[15], in[16], in[17], in[18], MIX); }
    { FRESH_CTX(cc); phase_outs_l1(cc, P, out); }
    GRID_BAR();
    layer_tail<1>(c, bar, in, ws, out);
}

extern "C" void kernel_launch(void* const* d_in, const int* in_sizes, int n_in, void* d_out, int out_size, void* d_ws, size_t ws_size, hipStream_t stream) {
    static int grid = 0;
    if (grid == 0) {
        if (n_in != 28 || ws_size < WS_END) { fprintf(stderr, "kernel_launch: unexpected n_in %d / ws_size %zu (need %zu)\n", n_in, ws_size, (size_t)WS_END); grid = -1; return; }
        int dev = 0, cus = 0, per_cu = 0;
        if (hipGetDevice(&dev) != hipSuccess || hipDeviceGetAttribute(&cus, hipDeviceAttributeMultiprocessorCount, dev) != hipSuccess) { grid = -1; return; }
        if (hipFuncSetAttribute((const void*)fwd_megakernel, hipFuncAttributeMaxDynamicSharedMemorySize, LDS_BYTES) != hipSuccess) { fprintf(stderr, "kernel_launch: hipFuncSetAttribute failed\n"); grid = -1; return; }
        if (hipOccupancyMaxActiveBlocksPerMultiprocessor(&per_cu, (const void*)fwd_megakernel, NTHREADS, LDS_BYTES) != hipSuccess || per_cu < 1) { fprintf(stderr, "kernel_launch: occupancy query says %d blocks per CU\n", per_cu); (void)hipGetLastError(); per_cu = 1; }
        grid = cus;
    }
    if (grid < 0) return;
    (void)hipMemsetAsync((char*)d_ws + WS_CTL, 0, CTL_ZERO_BYTES, stream);
    Params p{};
    for (int i = 0; i < 28; ++i) p.in[i] = (const float*)d_in[i];
    p.out = (float*)d_out; p.ws = (unsigned char*)d_ws;
    hipLaunchKernelGGL(fwd_megakernel, dim3(grid), dim3(NTHREADS), LDS_BYTES, stream, p);
}
```

```cpp
#include <hip/hip_runtime.h>
#include <cstdint>
#include <cstdio>

#define LAS __attribute__((address_space(3)))
typedef unsigned short bf16_t;
typedef short bf16x8 __attribute__((ext_vector_type(8)));
typedef float f32x4 __attribute__((ext_vector_type(4)));
typedef unsigned v4u __attribute__((ext_vector_type(4)));
typedef unsigned v2u __attribute__((ext_vector_type(2)));

constexpr int D = 1024;
constexpr int NB = 4, SEQ = 4096, NMETA = 16, TP = SEQ + NMETA  , PADF = 48, TPP = TP + PADF  ;
constexpr int NS = 8, TS = 64;
constexpr int MP_PROMPT = NB * TPP;
constexpr int MP = MP_PROMPT + NS * TS;
constexpr int NTILE64 = MP / 64;
constexpr int AB_IN = 2304, CD_IN = 3072, FH = 2816;
constexpr float ALPHA = 1.4142135623730951f;
constexpr int NTHREADS = 512, NWAVES = 8;

constexpr size_t O_YP = 0, O_YS = 16777216, O_KAP = 17301504, O_VAP = 17367040, O_CBP = 17432576, O_CCP = 17436672,
                 O_HGP = 17498112, O_KAS = 17760256, O_VAS = 17891328, O_CBS = 18022400, O_CCS = 18030592, O_HGS = 18153472;

constexpr size_t WS_CTL = 0, CTL_ZERO_BYTES = 65536;
constexpr size_t WS_WAB_IN = 1u << 20;
constexpr size_t WS_WAB_O = WS_WAB_IN + (size_t)AB_IN * D * 2;
constexpr size_t WS_WCD_IN = WS_WAB_O + (size_t)D * D * 2;
constexpr size_t WS_WCD_O = WS_WCD_IN + (size_t)CD_IN * D * 2;
constexpr size_t WS_WGU = WS_WCD_O + (size_t)D * D * 2;
constexpr size_t WS_WDN = WS_WGU + (size_t)2 * 2 * FH * D * 2;
constexpr size_t WS_LB = WS_WDN + (size_t)2 * D * FH * 2;
constexpr size_t WS_HB = WS_LB + 4096;
constexpr size_t WS_P = WS_HB + (size_t)MP * D * 2;
constexpr size_t WS_MIX = WS_P + (size_t)MP * CD_IN * 2;
constexpr size_t WS_SPARE = WS_MIX + (size_t)MP * D * 2;
constexpr size_t WS_END = WS_SPARE + (size_t)MP * 512 * 4;
static_assert(WS_END <= 268435456, "workspace map");
constexpr int CW_BAR = 4096;

constexpr int LDS_SCRATCH = 131072, LDSCTL_OFF = LDS_SCRATCH, LDS_BYTES = 147456;

__device__ __forceinline__ bf16_t f2bf(float f) { unsigned u = __float_as_uint(f); u += 0x7fffu + ((u >> 16) & 1u); return (bf16_t)(u >> 16); }
__device__ __forceinline__ unsigned pk2(float lo, float hi) { return (unsigned)f2bf(lo) | ((unsigned)f2bf(hi) << 16); }
__device__ __forceinline__ float bf2f(bf16_t h) { return __uint_as_float(((unsigned)h) << 16); }
__device__ __forceinline__ float sigmoidf_(float x) { return 1.0f / (1.0f + __expf(-x)); }
__device__ __forceinline__ float siluf_(float x) { return x / (1.0f + __expf(-x)); }
__device__ __forceinline__ bf16x8 pack8(f32x4 a, f32x4 b) { v4u w; w.x = pk2(a[0], a[1]); w.y = pk2(a[2], a[3]); w.z = pk2(b[0], b[1]); w.w = pk2(b[2], b[3]); return __builtin_bit_cast(bf16x8, w); }
__device__ __forceinline__ float wave_sum(float v) {
#pragma unroll
    for (int o = 1; o < 64; o <<= 1) v += __shfl_xor(v, o);
    return v;
}

#define XB_TMO      128
#define XB_XCNT(j)  (256  + 64 * (j))
#define XB_XSUB(j)  (1280 + 64 * (j))
#define XB_XGEN(j)  (2304 + 64 * (j))
#define XB_TOP      3328
#define XB_TOPGEN   3392
#define XCD_BAR_WORDS 3456
#define XB_SPIN_CAP (1u << 18)
__device__ __forceinline__ unsigned xb_ld(unsigned* p)              { return __hip_atomic_load(p, __ATOMIC_RELAXED, __HIP_MEMORY_SCOPE_AGENT); }
__device__ __forceinline__ unsigned xb_add(unsigned* p, unsigned v) { return __hip_atomic_fetch_add(p, v, __ATOMIC_RELAXED, __HIP_MEMORY_SCOPE_AGENT); }
__device__ __forceinline__ unsigned xb_xcc_id() { return (unsigned)__builtin_amdgcn_s_getreg((3 << 11) | 20) & 0xFu; }
#define XB_SPIN(cond, bar) do { unsigned _sp = 0; while (cond) { __builtin_amdgcn_s_sleep(1); \
    if ((++_sp & 255u) == 0u) { if (xb_ld(&(bar)[XB_TMO])) break; if (_sp > XB_SPIN_CAP) { atomicAdd(&(bar)[XB_TMO], 1u); break; } } } } while (0)
struct XcdBarrier { unsigned* bar; unsigned x; volatile LAS unsigned* st; };
__device__ __forceinline__ XcdBarrier xcd_barrier_post(unsigned* bar, volatile LAS unsigned* st) {
    XcdBarrier b; b.bar = bar; b.x = xb_xcc_id(); b.st = st;
    if (threadIdx.x == 0) (void)xb_add(&bar[XB_XCNT(b.x)], 1u);
    return b;
}
__device__ __forceinline__ void xcd_barrier_complete(unsigned* bar, unsigned x, unsigned& nloc, unsigned& nx) {
    const unsigned G = gridDim.x * gridDim.y * gridDim.z;
    unsigned sum, cnt, mine, sp = 0u;
    for (;;) {
        sum = 0u; cnt = 0u; mine = 0u;
#pragma unroll
        for (unsigned j = 0; j < 16; ++j) { const unsigned c = xb_ld(&bar[XB_XCNT(j)]); sum += c; cnt += (c > 0u) ? 1u : 0u; mine = (j == x) ? c : mine; }
        if (sum == G) break;
        __builtin_amdgcn_s_sleep(1);
        if ((++sp & 255u) == 0u) { if (xb_ld(&bar[XB_TMO])) break; if (sp > XB_SPIN_CAP) { atomicAdd(&bar[XB_TMO], 1u); break; } }
    }
    nloc = mine > 0u ? mine : 1u; nx = cnt > 0u ? cnt : 1u;
}
__device__ __forceinline__ void xcd_barrier(const XcdBarrier& b) {
    asm volatile("s_waitcnt vmcnt(0)" ::: "memory");
    __syncthreads();
    if (threadIdx.x == 0) {
        unsigned* bar = b.bar;
        __builtin_amdgcn_s_waitcnt(0);
        unsigned nloc = b.st[0], nx = b.st[1];
        if (nloc == 0u) { xcd_barrier_complete(bar, b.x, nloc, nx); b.st[0] = nloc; b.st[1] = nx; }
        const unsigned old = xb_add(&bar[XB_XSUB(b.x)], 1u);
        const unsigned gen = old / nloc;
        if (old + 1u == (gen + 1u) * nloc) {
            __builtin_amdgcn_fence(__ATOMIC_RELEASE, "agent");
            asm volatile("s_waitcnt vmcnt(0)" ::: "memory");
            const unsigned og = xb_add(&bar[XB_TOP], 1u);
            const unsigned tg = og / nx;
            if (og + 1u == (tg + 1u) * nx) xb_add(&bar[XB_TOPGEN], 1u);
            else XB_SPIN(xb_ld(&bar[XB_TOPGEN]) == tg, bar);
            __builtin_amdgcn_fence(__ATOMIC_ACQUIRE, "agent");
            xb_add(&bar[XB_XGEN(b.x)], 1u);
            asm volatile("s_waitcnt vmcnt(0)" ::: "memory");
        } else {
            XB_SPIN(xb_ld(&bar[XB_XGEN(b.x)]) == gen, bar);
            __builtin_amdgcn_fence(__ATOMIC_ACQUIRE, "agent");
            asm volatile("s_waitcnt vmcnt(0)" ::: "memory");
        }
    }
    __syncthreads();
}

namespace pg8 {
#define PG8_LAS __attribute__((address_space(3)))
typedef unsigned short bf16_t;
typedef short bf16x8 __attribute__((ext_vector_type(8)));
typedef float f32x4 __attribute__((ext_vector_type(4)));
typedef unsigned u32x4 __attribute__((ext_vector_type(4)));
constexpr int BM = 256, BK = 64, HALF = 128, HTB = HALF * BK * 2  , STAGE_BYTES = 8 * HTB, NXCD = 8, WGM = 8;

__host__ __device__ __forceinline__ int lds_byte(int r, int c) { const int st = (r >> 4) * 2 + (c >> 5), rr = r & 15, cc = c & 31, ob = rr * 64 + cc * 2; return st * 1024 + (ob ^ (((ob >> 9) & 1) << 5)); }
__host__ __device__ __forceinline__ void stage_rc(int b, int& R, int& C) { const int st = b / 1024, sb = b % 1024, swz = sb ^ (((sb >> 9) & 1) << 5); R = (st >> 1) * 16 + swz / 64; C = (st & 1) * 32 + (swz % 64) / 2; }
__host__ __device__ __forceinline__ int perm32(int rho) { const int n = rho >> 4, i = rho & 15; return 8 * (i >> 2) + 4 * n + (i & 3); }

struct Unit { int pm, pn; };
struct Gemm { const bf16_t* A; const bf16_t* Bt; int M, N, K; };

struct StaticOrder {
    int nM, nN, nwg, G, c;
    __host__ __device__ void init(int M, int N, int G_, int c_) { nM = M / BM; nN = N / BM; nwg = nM * nN; G = G_; c = c_; }
    __host__ __device__ bool next(int i, Unit& u) const {
        const long L = (long)i * G + c; if (L >= nwg) return false;
        int wgid = (int)L; { const int q = nwg / NXCD, r = nwg % NXCD, xcd = wgid % NXCD, off = wgid / NXCD; wgid = (xcd < r ? xcd * (q + 1) : r * (q + 1) + (xcd - r) * q) + off; }
        const int nig = WGM * nN, gid = wgid / nig, fm = gid * WGM, gsz = (nM - fm) < WGM ? (nM - fm) : WGM;
        u.pm = fm + ((wgid % nig) % gsz); u.pn = (wgid % nig) / gsz; return true;
    }
    __device__ __forceinline__ void a_ready(const Unit&) const {}
    __device__ __forceinline__ void done(const Unit&) const {}
};

__device__ __forceinline__ unsigned cvt_pk_bf16(float lo, float hi) { unsigned r; asm volatile("v_cvt_pk_bf16_f32 %0, %1, %2" : "=v"(r) : "v"(lo), "v"(hi)); return r; }
template <int ACT  > struct EpiBf16 {
    static constexpr bool PERM = true, AFTER_DRAIN = false; static_assert(ACT == 0, "EpiBf16: ACT is 0 (none)");
    bf16_t* O; int ldc; const float* bias; int split_cols; size_t split_stride; float scale0;
    __device__ __forceinline__ void operator()(const f32x4 (&acc)[2][2][4][2], const Unit& u, int wr, int wc, int fr, int fq) const {
        const int row0 = u.pm * BM + wr * 64 + fr; int colt = u.pn * BM; bf16_t* base = O;
        float sc = 1.f; if (split_cols) { const int t = colt / split_cols; base += (size_t)t * split_stride; colt -= t * split_cols; if (t == 0) sc = scale0; }
        const int col0 = colt + wc * 32 + 8 * fq, bcol0 = u.pn * BM + wc * 32 + 8 * fq;
        f32x4 bv[2][2];
#pragma unroll
        for (int bj = 0; bj < 2; ++bj)
#pragma unroll
            for (int n = 0; n < 2; ++n) bv[bj][n] = bias ? *(const f32x4*)(bias + bcol0 + bj * HALF + 4 * n) : (f32x4){0.f, 0.f, 0.f, 0.f};
#pragma unroll
        for (int ai = 0; ai < 2; ++ai)
#pragma unroll
            for (int m = 0; m < 4; ++m) { bf16_t* rowp = base + (size_t)(row0 + ai * HALF + m * 16) * ldc + col0;
#pragma unroll
                for (int bj = 0; bj < 2; ++bj) { f32x4 v0 = acc[ai][bj][m][0] + bv[bj][0], v1 = acc[ai][bj][m][1] + bv[bj][1];
                    v0 = v0 * sc; v1 = v1 * sc; u32x4 w; w.x = cvt_pk_bf16(v0[0], v0[1]); w.y = cvt_pk_bf16(v0[2], v0[3]); w.z = cvt_pk_bf16(v1[0], v1[1]); w.w = cvt_pk_bf16(v1[2], v1[3]);
                    *(u32x4*)(rowp + bj * HALF) = w; } }
    }
};

struct EpiF32 {
    static constexpr bool PERM = false, AFTER_DRAIN = false;
    float* C; int ldc;
    __device__ __forceinline__ void operator()(const f32x4 (&acc)[2][2][4][2], const Unit& u, int wr, int wc, int fr, int fq) const {
        const int row0 = u.pm * BM + wr * 64 + fr, col0 = u.pn * BM + wc * 32 + 4 * fq;
#pragma unroll
        for (int ai = 0; ai < 2; ++ai)
#pragma unroll
            for (int m = 0; m < 4; ++m) { float* rowp = C + (size_t)(row0 + ai * HALF + m * 16) * ldc + col0;
#pragma unroll
                for (int bj = 0; bj < 2; ++bj)
#pragma unroll
                    for (int n = 0; n < 2; ++n) *(f32x4*)(rowp + bj * HALF + n * 16) = acc[ai][bj][m][n]; }
    }
};
struct EpiGU {
    static constexpr bool PERM = true, AFTER_DRAIN = false;
    bf16_t* O; int ldc;
    __device__ __forceinline__ void operator()(const f32x4 (&acc)[2][2][4][2], const Unit& u, int wr, int wc, int fr, int fq) const {
        const int row0 = u.pm * BM + wr * 64 + fr, col0 = u.pn * HALF + wc * 32 + 8 * fq;
#pragma unroll
        for (int ai = 0; ai < 2; ++ai)
#pragma unroll
            for (int m = 0; m < 4; ++m) { bf16_t* rowp = O + (size_t)(row0 + ai * HALF + m * 16) * ldc + col0;
                f32x4 h0, h1;
#pragma unroll
                for (int r = 0; r < 4; ++r) { const float g0 = acc[ai][0][m][0][r], g1 = acc[ai][0][m][1][r];
                    h0[r] = g0 * __builtin_amdgcn_rcpf(1.0f + __expf(-g0)) * acc[ai][1][m][0][r]; h1[r] = g1 * __builtin_amdgcn_rcpf(1.0f + __expf(-g1)) * acc[ai][1][m][1][r]; }
                u32x4 w; w.x = cvt_pk_bf16(h0[0], h0[1]); w.y = cvt_pk_bf16(h0[2], h0[3]); w.z = cvt_pk_bf16(h1[0], h1[1]); w.w = cvt_pk_bf16(h1[2], h1[3]);
                *(u32x4*)rowp = w; }
    }
};

template <class Epi, class Sched, bool ALIGN_EPI = false, bool SP2 = false>
__device__ __forceinline__ void gemm_phase(PG8_LAS unsigned char* lds, const Gemm g, const Sched& S, const Epi& E) {
    const int tid = threadIdx.x, wid = __builtin_amdgcn_readfirstlane(tid >> 6), lane = tid & 63, wr = wid >> 2, wc = wid & 3, fr = lane & 15, fq = lane >> 4;
    const int K = g.K, nt = K / BK;
    unsigned voffA[2], voffB[2];
#pragma unroll
    for (int i = 0; i < 2; ++i) { int R, C; stage_rc(tid * 16 + i * 8192, R, C); const int Rb = Epi::PERM ? ((R & ~31) + perm32(R & 31)) : R;
        voffA[i] = (unsigned)(R * K + C) * 2u; voffB[i] = (unsigned)(Rb * K + C) * 2u; }
    const size_t kstep = (size_t)(BK * 2);
    const size_t hstep = (size_t)HALF * K * 2;
    const size_t tstep = 2 * hstep;
    const unsigned ldsw = (unsigned)wid * 1024u;
    const int aoff = lds_byte(wr * 64 + fr, fq * 8), boff = lds_byte(wc * 32 + fr, fq * 8);
#define PG8_SA(b, h) (((b) * 2 + (h)) * HTB)
#define PG8_SB(b, h) ((4 + (b) * 2 + (h)) * HTB)
#define PG8_STAGE(bufoff, gbase, voff) do { _Pragma("unroll") for (int _i = 0; _i < 2; ++_i) \
        __builtin_amdgcn_global_load_lds((const unsigned*)((const char*)(gbase) + (voff)[_i]), (PG8_LAS unsigned*)(lds + (bufoff) + ldsw + _i * 8192), 16, 0, 0); } while (0)
#define PG8_LDA(dst, b, h) do { _Pragma("unroll") for (int m = 0; m < 4; ++m) _Pragma("unroll") for (int k = 0; k < 2; ++k) dst[m][k] = *(const PG8_LAS bf16x8*)(lds + PG8_SA(b, h) + aoff + m * 2048 + k * 1024); } while (0)
#define PG8_LDB(dst, b, h) do { _Pragma("unroll") for (int n = 0; n < 2; ++n) _Pragma("unroll") for (int k = 0; k < 2; ++k) dst[n][k] = *(const PG8_LAS bf16x8*)(lds + PG8_SB(b, h) + boff + n * 2048 + k * 1024); } while (0)
#define PG8_MMA(ai, bj, At, Bt) do { __builtin_amdgcn_s_setprio(1); _Pragma("unroll") for (int m = 0; m < 4; ++m) _Pragma("unroll") for (int n = 0; n < 2; ++n) _Pragma("unroll") for (int k = 0; k < 2; ++k) \
        acc[ai][bj][m][n] = __builtin_amdgcn_mfma_f32_16x16x32_bf16(Bt[n][k], At[m][k], acc[ai][bj][m][n], 0, 0, 0); __builtin_amdgcn_s_setprio(0); } while (0)
#define PG8_WAIT_V(n) asm volatile("s_waitcnt vmcnt(" #n ")" ::: "memory")
#define PG8_WAIT_L(n) asm volatile("s_waitcnt lgkmcnt(" #n ")" ::: "memory")
#define PG8_BAR __builtin_amdgcn_s_barrier()
#define PG8_SCHED __builtin_amdgcn_sched_barrier(0)
    Unit cur, nxt; int ui = 0;
    if (!S.next(0, cur)) return;
    f32x4 acc[2][2][4][2];
#pragma unroll
    for (int a = 0; a < 2; ++a)
#pragma unroll
        for (int b = 0; b < 2; ++b)
#pragma unroll
            for (int m = 0; m < 4; ++m)
#pragma unroll
                for (int n = 0; n < 2; ++n) acc[a][b][m][n] = (f32x4){0.f, 0.f, 0.f, 0.f};
    bf16x8 At[4][2], B0[2][2], B1[2][2];
    const char* cA = (const char*)g.A + (size_t)cur.pm * tstep; const char* cB = (const char*)g.Bt + (size_t)cur.pn * tstep;
    S.a_ready(cur);
    if constexpr (SP2) {
        PG8_STAGE(PG8_SB(0, 0), cB, voffB); PG8_STAGE(PG8_SB(0, 1), cB + hstep, voffB); PG8_STAGE(PG8_SA(0, 0), cA, voffA); PG8_STAGE(PG8_SA(0, 1), cA + hstep, voffA);
        if (wr == 1) PG8_BAR;
        PG8_WAIT_V(2); PG8_BAR;
        PG8_STAGE(PG8_SB(1, 0), cB + kstep, voffB); PG8_STAGE(PG8_SA(1, 0), cA + kstep, voffA); PG8_STAGE(PG8_SB(1, 1), cB + hstep + kstep, voffB);
        PG8_WAIT_V(6); PG8_BAR;
    } else {
        PG8_STAGE(PG8_SB(0, 0), cB, voffB); PG8_STAGE(PG8_SA(0, 0), cA, voffA); PG8_STAGE(PG8_SB(0, 1), cB + hstep, voffB); PG8_STAGE(PG8_SA(0, 1), cA + hstep, voffA);
        if (wr == 1) PG8_BAR;
        PG8_WAIT_V(4); PG8_BAR;
        PG8_STAGE(PG8_SB(1, 0), cB + kstep, voffB); PG8_STAGE(PG8_SA(1, 0), cA + kstep, voffA); PG8_STAGE(PG8_SB(1, 1), cB + hstep + kstep, voffB);
        PG8_WAIT_V(6); PG8_BAR;
    }
    for (;;) {
        const bool has_next = S.next(ui + 1, nxt);
        const char* nA = has_next ? (const char*)g.A + (size_t)nxt.pm * tstep : cA; const char* nB = has_next ? (const char*)g.Bt + (size_t)nxt.pn * tstep : cB;
        for (int t = 0; t < nt; t += 2) {
            const bool last = (t == nt - 2);
            const char* a1 = cA + (size_t)(t + 1) * kstep;
            const char* a2 = last ? nA : cA + (size_t)(t + 2) * kstep; const char* b2 = last ? nB : cB + (size_t)(t + 2) * kstep;
            const char* a3 = a2 + kstep; const char* b3 = b2 + kstep;
            if (last && has_next) S.a_ready(nxt);
            if constexpr (SP2) {
            PG8_LDB(B0, 0, 0); PG8_LDB(B1, 0, 1); PG8_SCHED; PG8_LDA(At, 0, 0); PG8_STAGE(PG8_SA(1, 1), a1 + hstep, voffA);
            PG8_WAIT_V(8); PG8_WAIT_L(0); PG8_BAR; PG8_MMA(0, 0, At, B0); PG8_MMA(0, 1, At, B1); PG8_BAR; PG8_SCHED;
            PG8_LDA(At, 0, 1); PG8_STAGE(PG8_SB(0, 0), b2, voffB); PG8_STAGE(PG8_SB(0, 1), b2 + hstep, voffB); PG8_STAGE(PG8_SA(0, 0), a2, voffA);
            PG8_WAIT_V(8); PG8_WAIT_L(0); PG8_BAR; PG8_MMA(1, 0, At, B0); PG8_MMA(1, 1, At, B1); PG8_BAR; PG8_SCHED;
            PG8_LDB(B0, 1, 0); PG8_LDB(B1, 1, 1); PG8_SCHED; PG8_LDA(At, 1, 0); PG8_STAGE(PG8_SA(0, 1), a2 + hstep, voffA);
            PG8_WAIT_V(8); PG8_WAIT_L(0); PG8_BAR; PG8_MMA(0, 0, At, B0); PG8_MMA(0, 1, At, B1); PG8_BAR; PG8_SCHED;
            PG8_LDA(At, 1, 1); PG8_STAGE(PG8_SB(1, 0), b3, voffB); PG8_STAGE(PG8_SB(1, 1), b3 + hstep, voffB); PG8_STAGE(PG8_SA(1, 0), a3, voffA);
            PG8_WAIT_V(8); PG8_WAIT_L(0); PG8_BAR; PG8_MMA(1, 0, At, B0); PG8_MMA(1, 1, At, B1); PG8_BAR; PG8_SCHED;
            } else {
            PG8_LDB(B0, 0, 0); PG8_SCHED; PG8_LDA(At, 0, 0); PG8_STAGE(PG8_SA(1, 1), a1 + hstep, voffA);
            PG8_WAIT_L(8); PG8_BAR; PG8_WAIT_L(0); PG8_MMA(0, 0, At, B0); PG8_BAR; PG8_SCHED;
            PG8_LDB(B1, 0, 1); PG8_STAGE(PG8_SB(0, 0), b2, voffB);
            PG8_BAR; PG8_WAIT_L(0); PG8_MMA(0, 1, At, B1); PG8_BAR;
            PG8_LDA(At, 0, 1); PG8_STAGE(PG8_SA(0, 0), a2, voffA);
            PG8_BAR; PG8_WAIT_L(0); PG8_MMA(1, 0, At, B0); PG8_BAR; PG8_SCHED;
            PG8_STAGE(PG8_SB(0, 1), b2 + hstep, voffB);
            PG8_WAIT_V(6); PG8_BAR; PG8_MMA(1, 1, At, B1); PG8_BAR;
            PG8_LDB(B0, 1, 0); PG8_SCHED; PG8_LDA(At, 1, 0); PG8_STAGE(PG8_SA(0, 1), a2 + hstep, voffA);
            PG8_WAIT_L(8); PG8_BAR; PG8_WAIT_L(0); PG8_MMA(0, 0, At, B0); PG8_BAR; PG8_SCHED;
            PG8_LDB(B1, 1, 1); PG8_STAGE(PG8_SB(1, 0), b3, voffB);
            PG8_BAR; PG8_WAIT_L(0); PG8_MMA(0, 1, At, B1); PG8_BAR;
            PG8_LDA(At, 1, 1); PG8_STAGE(PG8_SA(1, 0), a3, voffA);
            PG8_BAR; PG8_WAIT_L(0); PG8_MMA(1, 0, At, B0); PG8_BAR; PG8_SCHED;
            PG8_STAGE(PG8_SB(1, 1), b3 + hstep, voffB);
            PG8_WAIT_V(6); PG8_BAR; PG8_MMA(1, 1, At, B1); PG8_BAR;
            }
        }
        if constexpr (ALIGN_EPI) { if (wr == 0) PG8_BAR; }
        if constexpr (!Epi::AFTER_DRAIN) { E(acc, cur, wr, wc, fr, fq); S.done(cur); }
        if (!has_next) break;
#pragma unroll
        for (int a = 0; a < 2; ++a)
#pragma unroll
            for (int b = 0; b < 2; ++b)
#pragma unroll
                for (int m = 0; m < 4; ++m)
#pragma unroll
                    for (int n = 0; n < 2; ++n) acc[a][b][m][n] = (f32x4){0.f, 0.f, 0.f, 0.f};
        cur = nxt; cA = nA; cB = nB; ++ui;
        if constexpr (ALIGN_EPI) { if (wr == 1) PG8_BAR; }
    }
    PG8_WAIT_V(0);
    if constexpr (!ALIGN_EPI) { if (wr == 0) PG8_BAR; }
    PG8_BAR;
    if constexpr (Epi::AFTER_DRAIN) { E.fused(acc, cur, wr, wc, fr, fq, lds, wid, lane); S.done(cur); }
#undef PG8_SA
#undef PG8_SB
#undef PG8_STAGE
#undef PG8_LDA
#undef PG8_LDB
#undef PG8_MMA
#undef PG8_WAIT_V
#undef PG8_WAIT_L
#undef PG8_BAR
#undef PG8_SCHED
}
}


struct Ctx { LAS unsigned char* lds; int tid, lane, wave, G, gw, NGW; };

template <bool GU>
__device__ __forceinline__ void transpose_item(const float* __restrict__ W, int K, int N, bf16_t* __restrict__ WT, LAS float* scr, int item, int lane) {
    const int nblk = N / 32, kb = item / nblk, nb = item % nblk, k0 = 64 * kb, n0 = 32 * nb;
#pragma unroll 8
    for (int i = 0; i < 32; ++i) { const int kk = 2 * i + (lane >> 5); scr[kk * 33 + (lane & 31)] = W[(size_t)(k0 + kk) * N + n0 + (lane & 31)]; }
    asm volatile("s_waitcnt lgkmcnt(0)" ::: "memory");
    const int c = lane & 7;
#pragma unroll
    for (int j = 0; j < 4; ++j) { const int n = (lane >> 3) + 8 * j; const LAS float* s = scr + (8 * c) * 33 + n;
        v4u o; o.x = pk2(s[0 * 33], s[1 * 33]); o.y = pk2(s[2 * 33], s[3 * 33]); o.z = pk2(s[4 * 33], s[5 * 33]); o.w = pk2(s[6 * 33], s[7 * 33]);
        const int nn = n0 + n, orow = GU ? (nn < FH ? (nn >> 7) * 256 + (nn & 127) : ((nn - FH) >> 7) * 256 + 128 + ((nn - FH) & 127)) : nn;
        *(v4u*)(WT + (size_t)orow * K + k0 + 8 * c) = o; }
    asm volatile("s_waitcnt lgkmcnt(0)" ::: "memory");
}
__device__ __forceinline__ void embed_row(const float* __restrict__ xp, const float* __restrict__ xs, const float* __restrict__ meta, bf16_t* __restrict__ Hb, int row, int lane) {
    const float* src = nullptr;
    if (row < MP_PROMPT) { const int b = row / TPP, p = row % TPP; if (p >= PADF) { const int i = p - PADF; src = i < NMETA ? meta + (size_t)i * D : xp + ((size_t)b * SEQ + (i - NMETA)) * D; } }
    else src = xs + (size_t)(row - MP_PROMPT) * D;
    v2u* o = (v2u*)(Hb + (size_t)row * D) + lane;
#pragma unroll
    for (int j = 0; j < 4; ++j) { v2u w = {0u, 0u}; if (src) { const f32x4 v = ((const f32x4*)src)[lane + 64 * j]; w.x = pk2(v[0], v[1]); w.y = pk2(v[2], v[3]); } o[64 * j] = w; }
}
#define in_(i) KIN_FWD(i)
__device__ __forceinline__ unsigned long long karg_raw(int i);
#define KIN_FWD(i) ((const float*)(const __attribute__((address_space(1))) float*)karg_raw(i))
__device__ __forceinline__ void phase_prologue(const Ctx& c, const float* const*, unsigned char* ws) {
    LAS float* scr = (LAS float*)(c.lds + c.wave * 16384);
    constexpr int I_ABI = 16 * (AB_IN / 32), I_O = 16 * 32, I_CDI = 16 * (CD_IN / 32), I_GU = 16 * (2 * FH / 32), I_DN = (FH / 64) * 32;
    constexpr int NITEMS = I_ABI + I_O + I_CDI + I_O + 2 * I_GU + 2 * I_DN;
    for (int it = c.gw; it < NITEMS; it += c.NGW) {
        int r = it;
        if (r < I_ABI) { transpose_item<false>(in_(8), D, AB_IN, (bf16_t*)(ws + WS_WAB_IN), scr, r, c.lane); continue; } r -= I_ABI;
        if (r < I_O) { transpose_item<false>(in_(12), D, D, (bf16_t*)(ws + WS_WAB_O), scr, r, c.lane); continue; } r -= I_O;
        if (r < I_CDI) { transpose_item<false>(in_(13), D, CD_IN, (bf16_t*)(ws + WS_WCD_IN), scr, r, c.lane); continue; } r -= I_CDI;
        if (r < I_O) { transpose_item<false>(in_(21), D, D, (bf16_t*)(ws + WS_WCD_O), scr, r, c.lane); continue; } r -= I_O;
        if (r < 2 * I_GU) { const int l = r / I_GU; transpose_item<true>(in_(26) + (size_t)l * D * 2 * FH, D, 2 * FH, (bf16_t*)(ws + WS_WGU) + (size_t)l * 2 * FH * D, scr, r % I_GU, c.lane); continue; } r -= 2 * I_GU;
        { const int l = r / I_DN; transpose_item<false>(in_(27) + (size_t)l * FH * D, FH, D, (bf16_t*)(ws + WS_WDN) + (size_t)l * D * FH, scr, r % I_DN, c.lane); }
    }
    for (int row = c.gw; row < MP; row += c.NGW) embed_row(in_(0), in_(1), in_(7), (bf16_t*)(ws + WS_HB), row, c.lane);
    if (blockIdx.x == 0) { const int ch = c.tid; const float l0 = in_(19)[ch], l1 = in_(19)[512 + ch]; const float m = fmaxf(l0, l1); const float e0 = expf(l0 - m), e1 = expf(l1 - m); ((float*)(ws + WS_LB))[ch] = e1 / (e0 + e1); }
}

__device__ __forceinline__ void phase_ln_residual(const Ctx& c, bf16_t* __restrict__ Hb, const float* __restrict__ mix, const float* __restrict__ g, const float* __restrict__ b, float* __restrict__ outf) {
    for (int row = c.gw; row < MP; row += c.NGW) {
        f32x4 y[4]; float s = 0.f;
        const v2u* hp = (const v2u*)(Hb + (size_t)row * D) + c.lane; const f32x4* mp = (const f32x4*)(mix + (size_t)row * D) + c.lane;
#pragma unroll
        for (int j = 0; j < 4; ++j) { const v2u hw = hp[64 * j]; const f32x4 mv = mp[64 * j];
            y[j][0] = ALPHA * __uint_as_float(hw.x << 16) + mv[0]; y[j][1] = ALPHA * __uint_as_float(hw.x & 0xffff0000u) + mv[1];
            y[j][2] = ALPHA * __uint_as_float(hw.y << 16) + mv[2]; y[j][3] = ALPHA * __uint_as_float(hw.y & 0xffff0000u) + mv[3];
            s += (y[j][0] + y[j][1]) + (y[j][2] + y[j][3]); }
        const float mu = wave_sum(s) * (1.0f / D); float q = 0.f;
#pragma unroll
        for (int j = 0; j < 4; ++j) { y[j] = y[j] - mu; q += (y[j][0] * y[j][0] + y[j][1] * y[j][1]) + (y[j][2] * y[j][2] + y[j][3] * y[j][3]); }
        const float rstd = rsqrtf(wave_sum(q) * (1.0f / D) + 1e-5f);
        float* op = nullptr;
        if (outf) { if (row < MP_PROMPT) { const int bb = row / TPP, p = row % TPP; if (p >= PADF + NMETA) op = outf + O_YP + ((size_t)bb * SEQ + (p - PADF - NMETA)) * D; } else op = outf + O_YS + (size_t)(row - MP_PROMPT) * D; }
        v2u* ho = (v2u*)(Hb + (size_t)row * D) + c.lane;
#pragma unroll
        for (int j = 0; j < 4; ++j) { const f32x4 gv = ((const f32x4*)g)[c.lane + 64 * j], bv = ((const f32x4*)b)[c.lane + 64 * j]; const f32x4 v = y[j] * rstd * gv + bv;
            v2u w; w.x = pk2(v[0], v[1]); w.y = pk2(v[2], v[3]); ho[64 * j] = w; if (op) ((f32x4*)op)[c.lane + 64 * j] = v; }
    }
}

__device__ __forceinline__ int kperm32(int kl) { return kl < 16 ? (kl >> 2) * 8 + (kl & 3) : ((kl - 16) >> 2) * 8 + 4 + (kl & 3); }
__device__ __forceinline__ void phase_attn(const Ctx& c, const bf16_t* __restrict__ P0, const float* __restrict__ ck, const float* __restrict__ cv, const float* __restrict__ sinks, bf16_t* __restrict__ MIX, float* __restrict__ out) {
    LAS bf16_t* Ks = (LAS bf16_t*)c.lds;
    LAS bf16_t* VTs = Ks + 192 * 72;
    const int w = c.wave;
    for (int u = blockIdx.x; u < NTILE64 * 2; u += c.G) {
        int tid = c.tid; asm volatile("" : "+v"(tid));
        const int lane = tid & 63, fr = lane & 15, fq = lane >> 4;
        const int T = u >> 1, kvh = u & 1;
        const bool samp = T >= NB * 65; const int sq = T - NB * 65, cc = samp ? 0 : T % 65, bb = samp ? 0 : T / 65;
        const int row0 = T * 64;
        __syncthreads();
#pragma unroll 1
        for (int i = 0; i < 3; ++i) {
            const int cid = tid + 512 * i, j = cid >> 3, ch = cid & 7;
            v4u kw = {0u, 0u, 0u, 0u}, vw = {0u, 0u, 0u, 0u};
            if (samp && j < 128) {
                const float* kp = ck + (((size_t)sq * 128 + j) * 2 + kvh) * 64 + ch * 8; const float* vp = cv + (((size_t)sq * 128 + j) * 2 + kvh) * 64 + ch * 8;
                const f32x4 k0 = *(const f32x4*)kp, k1 = *(const f32x4*)(kp + 4), v0 = *(const f32x4*)vp, v1 = *(const f32x4*)(vp + 4);
                kw = (v4u){pk2(k0[0], k0[1]), pk2(k0[2], k0[3]), pk2(k1[0], k1[1]), pk2(k1[2], k1[3])}; vw = (v4u){pk2(v0[0], v0[1]), pk2(v0[2], v0[3]), pk2(v1[0], v1[1]), pk2(v1[2], v1[3])};
                if (j >= 64) { float* ko = out + O_KAS + (((size_t)sq * 128 + (j - 64)) * 2 + kvh) * 64 + ch * 8; float* vo = out + O_VAS + (((size_t)sq * 128 + (j - 64)) * 2 + kvh) * 64 + ch * 8;
                    *(f32x4*)ko = k0; *(f32x4*)(ko + 4) = k1; *(f32x4*)vo = v0; *(f32x4*)(vo + 4) = v1; }
            } else if (samp || (cc - 2) * 64 + j >= PADF) {
                const size_t r = (size_t)(row0 - 128 + j) * AB_IN + kvh * 64 + ch * 8;
                kw = *(const v4u*)(P0 + r + 512); vw = *(const v4u*)(P0 + r + 640);
                if (j >= 128 && (samp || cc >= 63)) {
                    const size_t orow = samp ? ((size_t)sq * 128 + 64 + (j - 128)) : ((size_t)bb * 128 + (cc - 63) * 64 + (j - 128));
                    float* ko = out + (samp ? O_KAS : O_KAP) + (orow * 2 + kvh) * 64 + ch * 8; float* vo = out + (samp ? O_VAS : O_VAP) + (orow * 2 + kvh) * 64 + ch * 8;
                    *(f32x4*)ko = (f32x4){__uint_as_float(kw.x << 16), __uint_as_float(kw.x & 0xffff0000u), __uint_as_float(kw.y << 16), __uint_as_float(kw.y & 0xffff0000u)};
                    *(f32x4*)(ko + 4) = (f32x4){__uint_as_float(kw.z << 16), __uint_as_float(kw.z & 0xffff0000u), __uint_as_float(kw.w << 16), __uint_as_float(kw.w & 0xffff0000u)};
                    *(f32x4*)vo = (f32x4){__uint_as_float(vw.x << 16), __uint_as_float(vw.x & 0xffff0000u), __uint_as_float(vw.y << 16), __uint_as_float(vw.y & 0xffff0000u)};
                    *(f32x4*)(vo + 4) = (f32x4){__uint_as_float(vw.z << 16), __uint_as_float(vw.z & 0xffff0000u), __uint_as_float(vw.w << 16), __uint_as_float(vw.w & 0xffff0000u)};
                }
            }
            *(LAS v4u*)(Ks + j * 72 + ch * 8) = kw;
            const int pos = (j & ~31) + kperm32(j & 31); LAS bf16_t* vt = VTs + (ch * 8) * 200 + pos;
            vt[0 * 200] = (bf16_t)(vw.x & 0xffffu); vt[1 * 200] = (bf16_t)(vw.x >> 16); vt[2 * 200] = (bf16_t)(vw.y & 0xffffu); vt[3 * 200] = (bf16_t)(vw.y >> 16);
            vt[4 * 200] = (bf16_t)(vw.z & 0xffffu); vt[5 * 200] = (bf16_t)(vw.z >> 16); vt[6 * 200] = (bf16_t)(vw.w & 0xffffu); vt[7 * 200] = (bf16_t)(vw.w >> 16);
        }
        __syncthreads();
        const int g = w >> 1, h = kvh * 4 + g, qh = w & 1;
        const float slope = exp2f(-(float)(h + 1)), sink = sinks[h];
        const int jmin = samp ? 0 : ((cc - 2) * 64 >= PADF ? 0 : PADF - (cc - 2) * 64);
#pragma unroll 1
        for (int qt = 0; qt < 2; ++qt) {
            const int t = 32 * qh + 16 * qt + fr;
            bf16x8 qf[2];
#pragma unroll
            for (int ds = 0; ds < 2; ++ds) qf[ds] = *(const bf16x8*)(P0 + (size_t)(row0 + t) * AB_IN + h * 64 + 32 * ds + 8 * fq);
            f32x4 sacc[12];
#pragma unroll
            for (int kt = 0; kt < 12; ++kt) { sacc[kt] = (f32x4){0.f, 0.f, 0.f, 0.f};
#pragma unroll
                for (int ds = 0; ds < 2; ++ds) { const bf16x8 a = *(const LAS bf16x8*)(Ks + (16 * kt + fr) * 72 + 32 * ds + 8 * fq); sacc[kt] = __builtin_amdgcn_mfma_f32_16x16x32_bf16(a, qf[ds], sacc[kt], 0, 0, 0); }
                if ((kt & 3) == 3) __builtin_amdgcn_sched_barrier(0); }
            float m = -1e30f;
#pragma unroll
            for (int kt = 0; kt < 12; ++kt)
#pragma unroll
                for (int r = 0; r < 4; ++r) { const int j = 16 * kt + 4 * fq + r; float sc = sacc[kt][r] * 0.125f - slope * fabsf((float)(128 + t - j)); sc = j >= jmin ? sc : -1e30f; sacc[kt][r] = sc; m = fmaxf(m, sc); }
            m = fmaxf(m, __shfl_xor(m, 16)); m = fmaxf(m, __shfl_xor(m, 32)); m = fmaxf(m, sink);
            float l = 0.f;
#pragma unroll
            for (int kt = 0; kt < 12; ++kt)
#pragma unroll
                for (int r = 0; r < 4; ++r) { const float p = __expf(sacc[kt][r] - m); sacc[kt][r] = p; l += p; }
            l += __shfl_xor(l, 16); l += __shfl_xor(l, 32); l += __expf(sink - m);
            const float inv = 1.0f / l;
            f32x4 oacc[4];
#pragma unroll
            for (int dt = 0; dt < 4; ++dt) oacc[dt] = (f32x4){0.f, 0.f, 0.f, 0.f};
#pragma unroll
            for (int ks = 0; ks < 6; ++ks) { const bf16x8 pb = pack8(sacc[2 * ks], sacc[2 * ks + 1]);
#pragma unroll
                for (int dt = 0; dt < 4; ++dt) { const bf16x8 a = *(const LAS bf16x8*)(VTs + (16 * dt + fr) * 200 + 32 * ks + 8 * fq); oacc[dt] = __builtin_amdgcn_mfma_f32_16x16x32_bf16(a, pb, oacc[dt], 0, 0, 0); }
                if (ks & 1) __builtin_amdgcn_sched_barrier(0); }
            bf16_t* op = MIX + (size_t)(row0 + t) * D + h * 64 + 4 * fq;
#pragma unroll
            for (int dt = 0; dt < 4; ++dt) { v2u o; o.x = pk2(oacc[dt][0] * inv, oacc[dt][1] * inv); o.y = pk2(oacc[dt][2] * inv, oacc[dt][3] * inv); *(v2u*)(op + 16 * dt) = o; }
        }
    }
    __syncthreads();
}

__device__ __forceinline__ void phase_convb(const Ctx& c, const bf16_t* __restrict__ P0, const float* __restrict__ stb, const float* __restrict__ w, bf16_t* __restrict__ MIX, float* __restrict__ out) {
    for (int it = blockIdx.x * NTHREADS + c.tid; it < MP * 64; it += c.G * NTHREADS) {
        const int row = it >> 6, ch = (it & 63) * 8;
        const bool samp = row >= MP_PROMPT; const int pos = samp ? (row - MP_PROMPT) % TS : row % TPP - PADF, sq = samp ? (row - MP_PROMPT) / TS : row / TPP;
        float u[3][8];
#pragma unroll
        for (int back = 0; back < 3; ++back) {
            if (pos - back >= 0) { const size_t r = (size_t)(row - back) * AB_IN + ch; const v4u cg = *(const v4u*)(P0 + r + 1280), hb = *(const v4u*)(P0 + r + 1792);
                u[back][0] = __uint_as_float(cg.x << 16) * __uint_as_float(hb.x << 16); u[back][1] = __uint_as_float(cg.x & 0xffff0000u) * __uint_as_float(hb.x & 0xffff0000u);
                u[back][2] = __uint_as_float(cg.y << 16) * __uint_as_float(hb.y << 16); u[back][3] = __uint_as_float(cg.y & 0xffff0000u) * __uint_as_float(hb.y & 0xffff0000u);
                u[back][4] = __uint_as_float(cg.z << 16) * __uint_as_float(hb.z << 16); u[back][5] = __uint_as_float(cg.z & 0xffff0000u) * __uint_as_float(hb.z & 0xffff0000u);
                u[back][6] = __uint_as_float(cg.w << 16) * __uint_as_float(hb.w << 16); u[back][7] = __uint_as_float(cg.w & 0xffff0000u) * __uint_as_float(hb.w & 0xffff0000u); }
            else if (samp) { const float* sp = stb + ((size_t)sq * 2 + (2 + pos - back)) * 512 + ch;
#pragma unroll
                for (int i = 0; i < 8; ++i) u[back][i] = sp[i]; }
            else {
#pragma unroll
                for (int i = 0; i < 8; ++i) u[back][i] = 0.f; }
        }
        const v4u bg = *(const v4u*)(P0 + (size_t)row * AB_IN + 768 + ch);
        float bgv[8] = {__uint_as_float(bg.x << 16), __uint_as_float(bg.x & 0xffff0000u), __uint_as_float(bg.y << 16), __uint_as_float(bg.y & 0xffff0000u),
                        __uint_as_float(bg.z << 16), __uint_as_float(bg.z & 0xffff0000u), __uint_as_float(bg.w << 16), __uint_as_float(bg.w & 0xffff0000u)};
        float o[8];
#pragma unroll
        for (int i = 0; i < 8; ++i) o[i] = bgv[i] * (w[ch + i] * u[2][i] + w[512 + ch + i] * u[1][i] + w[1024 + ch + i] * u[0][i]);
        *(v4u*)(MIX + (size_t)row * D + 512 + ch) = (v4u){pk2(o[0], o[1]), pk2(o[2], o[3]), pk2(o[4], o[5]), pk2(o[6], o[7])};
        const int last = samp ? TS : TP;
        if (pos >= last - 2) { float* sp = out + (samp ? O_CBS : O_CBP) + ((size_t)sq * 2 + (pos - (last - 2))) * 512 + ch; *(f32x4*)sp = (f32x4){u[0][0], u[0][1], u[0][2], u[0][3]}; *(f32x4*)(sp + 4) = (f32x4){u[0][4], u[0][5], u[0][6], u[0][7]}; }
    }
}

template <int BLK>
__device__ __forceinline__ void convc_block(const LAS bf16_t* utc, const float (&wt)[31], float (&win)[31], float (&ov)[64], float bias) {
#pragma unroll
    for (int p = 0; p < 31; ++p) { constexpr int base = 31 * BLK; const int si = base + p;
        if (si < 94) { win[p] = bf2f(utc[si * 512]);
            if (si >= 30) { float a = bias;
#pragma unroll
                for (int j = 0; j < 31; ++j) a += wt[j] * win[(p + 1 + j) % 31];
                ov[si - 30] = a; } } }
}
__device__ __forceinline__ void convc_tile(const Ctx& c, int T, const bf16_t* __restrict__ P1, const float* __restrict__ stc, const float* __restrict__ w, const float* __restrict__ cb, const float* __restrict__ lg, const float* __restrict__ lbv, bf16_t* __restrict__ MIX, float* __restrict__ out) {
    LAS bf16_t* ut = (LAS bf16_t*)c.lds;
    LAS float* stats = (LAS float*)(c.lds + 98304);
    int tid = c.tid; asm volatile("" : "+v"(tid));
    const int lane = tid & 63, wv_ = c.wave, ch = wv_ * 64 + lane;
    const bool samp = T >= NB * 65; const int sq = samp ? T - NB * 65 : T / 65, cc = samp ? 0 : T % 65, row0 = T * 64;
    const bool wstate = samp || cc == 64;
    __syncthreads();
    for (int it = tid; it < 94 * 64; it += NTHREADS) {
        const int si = it >> 6, c8 = (it & 63) * 8, ro = si - 30;
        float u[8];
        if (samp && ro < 0) { const float* sp = stc + ((size_t)sq * 30 + (30 + ro)) * 512 + c8;
#pragma unroll
            for (int i = 0; i < 8; ++i) u[i] = sp[i]; }
        else if (!samp && cc * 64 + ro < PADF) {
#pragma unroll
            for (int i = 0; i < 8; ++i) u[i] = 0.f; }
        else { const size_t r = (size_t)(row0 + ro) * CD_IN + c8; const v4u a = *(const v4u*)(P1 + r), g = *(const v4u*)(P1 + r + 512);
            u[0] = __uint_as_float(a.x << 16) * sigmoidf_(__uint_as_float(g.x << 16)); u[1] = __uint_as_float(a.x & 0xffff0000u) * sigmoidf_(__uint_as_float(g.x & 0xffff0000u));
            u[2] = __uint_as_float(a.y << 16) * sigmoidf_(__uint_as_float(g.y << 16)); u[3] = __uint_as_float(a.y & 0xffff0000u) * sigmoidf_(__uint_as_float(g.y & 0xffff0000u));
            u[4] = __uint_as_float(a.z << 16) * sigmoidf_(__uint_as_float(g.z << 16)); u[5] = __uint_as_float(a.z & 0xffff0000u) * sigmoidf_(__uint_as_float(g.z & 0xffff0000u));
            u[6] = __uint_as_float(a.w << 16) * sigmoidf_(__uint_as_float(g.w << 16)); u[7] = __uint_as_float(a.w & 0xffff0000u) * sigmoidf_(__uint_as_float(g.w & 0xffff0000u)); }
        *(LAS v4u*)(ut + si * 512 + c8) = (v4u){pk2(u[0], u[1]), pk2(u[2], u[3]), pk2(u[4], u[5]), pk2(u[6], u[7])};
        if (wstate && ro >= 34) { float* sp = out + (samp ? O_CCS : O_CCP) + ((size_t)sq * 30 + (ro - 34)) * 512 + c8; *(f32x4*)sp = (f32x4){u[0], u[1], u[2], u[3]}; *(f32x4*)(sp + 4) = (f32x4){u[4], u[5], u[6], u[7]}; }
    }
    __syncthreads();
    float wt[31], win[31], ov[64];
#pragma unroll
    for (int j = 0; j < 31; ++j) wt[j] = w[j * 512 + ch];
    const float bias = cb[ch];
    convc_block<0>(ut + ch, wt, win, ov, bias); convc_block<1>(ut + ch, wt, win, ov, bias); convc_block<2>(ut + ch, wt, win, ov, bias); convc_block<3>(ut + ch, wt, win, ov, bias);
    __syncthreads();
#pragma unroll
    for (int r = 0; r < 64; ++r) ut[r * 512 + ch] = f2bf(ov[r]);
    __syncthreads();
#pragma unroll
    for (int i = 0; i < 8; ++i) { const int r = wv_ * 8 + i; const v4u x = *(const LAS v4u*)(ut + r * 512 + lane * 8);
        const float x0 = __uint_as_float(x.x << 16), x1 = __uint_as_float(x.x & 0xffff0000u), x2 = __uint_as_float(x.y << 16), x3 = __uint_as_float(x.y & 0xffff0000u),
                    x4 = __uint_as_float(x.z << 16), x5 = __uint_as_float(x.z & 0xffff0000u), x6 = __uint_as_float(x.w << 16), x7 = __uint_as_float(x.w & 0xffff0000u);
        const float mu = wave_sum(((x0 + x1) + (x2 + x3)) + ((x4 + x5) + (x6 + x7))) * (1.0f / 512.0f);
        const float d0 = x0 - mu, d1 = x1 - mu, d2 = x2 - mu, d3 = x3 - mu, d4 = x4 - mu, d5 = x5 - mu, d6 = x6 - mu, d7 = x7 - mu;
        const float var = wave_sum(((d0 * d0 + d1 * d1) + (d2 * d2 + d3 * d3)) + ((d4 * d4 + d5 * d5) + (d6 * d6 + d7 * d7))) * (1.0f / 512.0f);
        if (lane == 0) { stats[2 * r] = mu; stats[2 * r + 1] = rsqrtf(var + 1e-5f); } }
    __syncthreads();
    const float gch = lg[ch], bch = lbv[ch];
#pragma unroll
    for (int r = 0; r < 64; ++r) { const float mu = stats[2 * r], rs = stats[2 * r + 1]; MIX[(size_t)(row0 + r) * D + ch] = f2bf(siluf_((ov[r] - mu) * rs * gch + bch)); }
}

constexpr int HG_UNITS = NTILE64 * 4;
constexpr size_t WS_HQ = WS_SPARE, WS_ATT = WS_WGU, WS_DEC = WS_WGU + (size_t)HG_UNITS * 8192;
static_assert((size_t)HG_UNITS * 32768 <= (size_t)MP * 512 * 4 && (size_t)HG_UNITS * (8192 + 512) <= (size_t)2 * FH * D * 2, "hgrn workspace");

__device__ __forceinline__ void phase_hgrn_prep(const Ctx& c, const bf16_t* __restrict__ P1, const float* __restrict__ lb, unsigned char* __restrict__ ws) {
    LAS bf16_t* Qs = (LAS bf16_t*)c.lds;
    LAS bf16_t* Ks = Qs + 64 * 136;
    LAS float* segtot = (LAS float*)(Ks + 64 * 136);
    const int tid = c.tid, k = tid & 127, seg = tid >> 7, lane = c.lane, w = c.wave, fr = lane & 15, fq = lane >> 4;
    for (int u = blockIdx.x; u < HG_UNITS; u += c.G) {
        const int T = u >> 2, h = u & 3, row0 = T * 64;
        const int npad = (T < NB * 65 && (T % 65) == 0) ? PADF : 0;
        const float lbv = lb[h * 128 + k];
        float cum[16], qv[16], kv[16];
        float run = 0.f;
#pragma unroll
        for (int i = 0; i < 16; ++i) { const int t = seg * 16 + i; const size_t r = (size_t)(row0 + t) * CD_IN + h * 128 + k;
            const float fg = lbv + (1.0f - lbv) * sigmoidf_(bf2f(P1[r + 1536])); const bool pad = t < npad;
            run += pad ? 0.f : __logf(fg); cum[i] = run; kv[i] = pad ? 0.f : 1.0f - fg; qv[i] = bf2f(P1[r + 1024]); }
        __syncthreads();
        segtot[seg * 128 + k] = run;
        __syncthreads();
        float off = 0.f, tot = 0.f;
#pragma unroll
        for (int s2 = 0; s2 < 4; ++s2) { const float v = segtot[s2 * 128 + k]; off += s2 < seg ? v : 0.f; tot += v; }
        unsigned kdp[8];
#pragma unroll
        for (int i = 0; i < 16; i += 2) {
            const int t = seg * 16 + i; const float c0 = cum[i] + off, c1 = cum[i + 1] + off;
            Qs[t * 136 + k] = f2bf(qv[i] * __expf(c0)); Qs[(t + 1) * 136 + k] = f2bf(qv[i + 1] * __expf(c1));
            Ks[t * 136 + k] = f2bf(kv[i] * __expf(-c0)); Ks[(t + 1) * 136 + k] = f2bf(kv[i + 1] * __expf(-c1));
            kdp[i >> 1] = pk2(kv[i] * __expf(tot - c0), kv[i + 1] * __expf(tot - c1));
        }
        bf16_t* KD = (bf16_t*)(ws + WS_HQ + (size_t)u * 32768 + 16384);
        *(v4u*)(KD + k * 64 + seg * 16) = (v4u){kdp[0], kdp[1], kdp[2], kdp[3]};
        *(v4u*)(KD + k * 64 + seg * 16 + 8) = (v4u){kdp[4], kdp[5], kdp[6], kdp[7]};
        if (seg == 0) ((float*)(ws + WS_DEC))[(size_t)u * 128 + k] = __expf(tot);
        __syncthreads();
        bf16_t* QT = (bf16_t*)(ws + WS_HQ + (size_t)u * 32768);
#pragma unroll
        for (int i = 0; i < 2; ++i) { const int cid = tid + 512 * i, t = cid >> 4, pc = cid & 15, k0 = 32 * (pc >> 2) + 4 * (pc & 3);
            const v2u lo = *(const LAS v2u*)(Qs + t * 136 + k0), hi = *(const LAS v2u*)(Qs + t * 136 + k0 + 16);
            *(v4u*)(QT + t * 128 + pc * 8) = (v4u){lo.x, lo.y, hi.x, hi.y}; }
        const int tt = w >> 1;
        bf16_t* ATT = (bf16_t*)(ws + WS_ATT + (size_t)u * 8192);
#pragma unroll
        for (int si = 0; si < 2; ++si) { const int ss = (w & 1) * 2 + si; f32x4 acc = {0.f, 0.f, 0.f, 0.f};
#pragma unroll
            for (int ks = 0; ks < 4; ++ks) { const bf16x8 a = *(const LAS bf16x8*)(Qs + (16 * tt + fr) * 136 + 32 * ks + 8 * fq), b = *(const LAS bf16x8*)(Ks + (16 * ss + fr) * 136 + 32 * ks + 8 * fq);
                acc = __builtin_amdgcn_mfma_f32_16x16x32_bf16(b, a, acc, 0, 0, 0); }
            const int t = 16 * tt + fr, s0 = 16 * ss + 4 * fq;
            v2u o; o.x = pk2(s0 <= t ? acc[0] : 0.f, s0 + 1 <= t ? acc[1] : 0.f); o.y = pk2(s0 + 2 <= t ? acc[2] : 0.f, s0 + 3 <= t ? acc[3] : 0.f);
            *(v2u*)(ATT + t * 64 + s0) = o; }
    }
    __syncthreads();
}

__device__ __forceinline__ void hgrn_chain(const Ctx& c, int chain, const bf16_t* __restrict__ P1, unsigned char* __restrict__ ws, const float* __restrict__ st_in, const float* __restrict__ ng, bf16_t* __restrict__ MIX, float* __restrict__ out) {
    LAS bf16_t* Qs = (LAS bf16_t*)c.lds;
    LAS bf16_t* KDs = Qs + 64 * 136;
    LAS bf16_t* ATs = KDs + 128 * 72;
    LAS bf16_t* VTs = ATs + 64 * 72;
    LAS float* DECs = (LAS float*)(VTs + 128 * 72);
    LAS float* PART = DECs + 128;
    const int tid = c.tid, lane = c.lane, w = c.wave, fr = lane & 15, fq = lane >> 4;
    const bool samp = chain >= 16; const int seq = samp ? (chain - 16) >> 2 : chain >> 2, h = chain & 3;
    const int nsteps = samp ? 1 : 65, T0 = samp ? NB * 65 + seq : seq * 65;
    f32x4 S[8];
#pragma unroll
    for (int kt = 0; kt < 8; ++kt)
#pragma unroll
        for (int r = 0; r < 4; ++r) S[kt][r] = samp ? st_in[(((size_t)seq * 4 + h) * 128 + 16 * kt + 4 * fq + r) * 128 + 16 * w + fr] : 0.f;
    const float ngv = ng[h * 128 + 16 * w + fr];
    v4u rq[2], rk[2], ra, rv[2]; float rd = 0.f;
#define HG_LOAD(T_) do { const int u_ = (T_) * 4 + h; const bf16_t* QT_ = (const bf16_t*)(ws + WS_HQ + (size_t)u_ * 32768); const bf16_t* KD_ = QT_ + 8192; \
        _Pragma("unroll") for (int i = 0; i < 2; ++i) { const int cid = tid + 512 * i; rq[i] = *(const v4u*)(QT_ + cid * 8); rk[i] = *(const v4u*)(KD_ + cid * 8); \
            rv[i] = *(const v4u*)(P1 + (size_t)((T_) * 64 + (cid >> 4)) * CD_IN + 2048 + h * 128 + (cid & 15) * 8); } \
        ra = *(const v4u*)((const bf16_t*)(ws + WS_ATT + (size_t)u_ * 8192) + tid * 8); \
        if (tid < 128) rd = ((const float*)(ws + WS_DEC))[(size_t)u_ * 128 + tid]; } while (0)
    HG_LOAD(T0);
    for (int n = 0; n < nsteps; ++n) {
        const int T = T0 + n;
        __syncthreads();
#pragma unroll
        for (int i = 0; i < 2; ++i) { const int cid = tid + 512 * i;
            *(LAS v4u*)(Qs + (cid >> 4) * 136 + (cid & 15) * 8) = rq[i];
            *(LAS v4u*)(KDs + (cid >> 3) * 72 + (cid & 7) * 8) = rk[i];
            const int t = cid >> 4, v0 = (cid & 15) * 8;
            VTs[(v0 + 0) * 72 + t] = (bf16_t)(rv[i].x & 0xffffu); VTs[(v0 + 1) * 72 + t] = (bf16_t)(rv[i].x >> 16);
            VTs[(v0 + 2) * 72 + t] = (bf16_t)(rv[i].y & 0xffffu); VTs[(v0 + 3) * 72 + t] = (bf16_t)(rv[i].y >> 16);
            VTs[(v0 + 4) * 72 + t] = (bf16_t)(rv[i].z & 0xffffu); VTs[(v0 + 5) * 72 + t] = (bf16_t)(rv[i].z >> 16);
            VTs[(v0 + 6) * 72 + t] = (bf16_t)(rv[i].w & 0xffffu); VTs[(v0 + 7) * 72 + t] = (bf16_t)(rv[i].w >> 16); }
        *(LAS v4u*)(ATs + (tid >> 3) * 72 + (tid & 7) * 8) = ra;
        if (tid < 128) DECs[tid] = rd;
        __syncthreads();
        if (n + 1 < nsteps) HG_LOAD(T + 1);
        bf16_t gv[16];
#pragma unroll
        for (int tt = 0; tt < 4; ++tt)
#pragma unroll
            for (int r = 0; r < 4; ++r) gv[tt * 4 + r] = P1[(size_t)(T * 64 + 16 * tt + 4 * fq + r) * CD_IN + 2560 + h * 128 + 16 * w + fr];
        bf16x8 bv[2];
#pragma unroll
        for (int s2 = 0; s2 < 2; ++s2) bv[s2] = *(const LAS bf16x8*)(VTs + (16 * w + fr) * 72 + 32 * s2 + 8 * fq);
        f32x4 o[4];
#pragma unroll
        for (int tt = 0; tt < 4; ++tt) o[tt] = (f32x4){0.f, 0.f, 0.f, 0.f};
#pragma unroll
        for (int ks = 0; ks < 4; ++ks) { const bf16x8 sb = pack8(S[2 * ks], S[2 * ks + 1]);
#pragma unroll
            for (int tt = 0; tt < 4; ++tt) { const bf16x8 a = *(const LAS bf16x8*)(Qs + (16 * tt + fr) * 136 + 32 * ks + 8 * fq); o[tt] = __builtin_amdgcn_mfma_f32_16x16x32_bf16(a, sb, o[tt], 0, 0, 0); } }
#pragma unroll
        for (int s2 = 0; s2 < 2; ++s2)
#pragma unroll
            for (int tt = 0; tt < 4; ++tt) { const bf16x8 a = *(const LAS bf16x8*)(ATs + (16 * tt + fr) * 72 + 32 * s2 + 8 * fq); o[tt] = __builtin_amdgcn_mfma_f32_16x16x32_bf16(a, bv[s2], o[tt], 0, 0, 0); }
#pragma unroll
        for (int kt = 0; kt < 8; ++kt) { const f32x4 d = *(const LAS f32x4*)(DECs + 16 * kt + 4 * fq); S[kt] = S[kt] * d;
#pragma unroll
            for (int s2 = 0; s2 < 2; ++s2) { const bf16x8 a = *(const LAS bf16x8*)(KDs + (16 * kt + fr) * 72 + 32 * s2 + 8 * fq); S[kt] = __builtin_amdgcn_mfma_f32_16x16x32_bf16(a, bv[s2], S[kt], 0, 0, 0); } }
#pragma unroll
        for (int tt = 0; tt < 4; ++tt)
#pragma unroll
            for (int r = 0; r < 4; ++r) { float q2 = o[tt][r] * o[tt][r]; q2 += __shfl_xor(q2, 1); q2 += __shfl_xor(q2, 2); q2 += __shfl_xor(q2, 4); q2 += __shfl_xor(q2, 8);
                if (fr == 0) PART[(16 * tt + 4 * fq + r) * 8 + w] = q2; }
        __syncthreads();
#pragma unroll
        for (int tt = 0; tt < 4; ++tt)
#pragma unroll
            for (int r = 0; r < 4; ++r) { const int t = 16 * tt + 4 * fq + r; const f32x4 p0 = *(const LAS f32x4*)(PART + t * 8), p1 = *(const LAS f32x4*)(PART + t * 8 + 4);
                const float ssum = ((p0[0] + p0[1]) + (p0[2] + p0[3])) + ((p1[0] + p1[1]) + (p1[2] + p1[3]));
                const float val = o[tt][r] * rsqrtf(ssum * (1.0f / 128.0f) + 1e-6f) * ngv * siluf_(bf2f(gv[tt * 4 + r]));
                MIX[(size_t)(T * 64 + t) * D + 512 + h * 128 + 16 * w + fr] = f2bf(val); }
    }
#undef HG_LOAD
    float* op = out + (samp ? O_HGS : O_HGP) + ((size_t)seq * 4 + h) * 16384 + 16 * w + fr;
#pragma unroll
    for (int kt = 0; kt < 8; ++kt)
#pragma unroll
        for (int r = 0; r < 4; ++r) op[(size_t)(16 * kt + 4 * fq + r) * 128] = S[kt][r];
    __syncthreads();
}

struct Params { const float* in[28]; float* out; unsigned char* ws; };
typedef __attribute__((address_space(4))) const unsigned long long kconst_u64;
__device__ __forceinline__ unsigned long long karg_raw(int i) { kconst_u64* kp = (kconst_u64*)__builtin_amdgcn_kernarg_segment_ptr(); asm volatile("" : "+s"(kp)); return kp[i]; }
#define GASP __attribute__((address_space(1)))
#define KIN(i) ((const float*)(const GASP float*)karg_raw(i))
#define KOUT() ((float*)(GASP float*)karg_raw(28))
#define KWS() ((unsigned char*)(GASP unsigned char*)karg_raw(29))
#define FRESH_CTX(c) Ctx c; { int t_ = threadIdx.x; asm volatile("" : "+v"(t_)); c.lds = (LAS unsigned char*)lds_raw; c.tid = t_; c.lane = t_ & 63; c.wave = __builtin_amdgcn_readfirstlane(t_ >> 6); \
        c.G = gridDim.x; c.gw = blockIdx.x * NWAVES + c.wave; c.NGW = c.G * NWAVES; }
#define GEMM_PHASE(EPI, A_, B_, N_, K_, ...) do { unsigned char* ws_ = KWS(); pg8::Gemm g_{(const bf16_t*)(ws_ + (A_)), (const bf16_t*)(ws_ + (B_)), MP, (N_), (K_)}; pg8::StaticOrder S_; S_.init(MP, (N_), (int)gridDim.x, (int)blockIdx.x); \
        EPI E_{__VA_ARGS__}; pg8::gemm_phase<EPI, pg8::StaticOrder, true, true>((LAS unsigned char*)lds_raw, g_, S_, E_); } while (0)

#define LAYER_TAIL(L) do { \
    GEMM_PHASE(pg8::EpiF32, WS_MIX, ((L) == 0 ? WS_WAB_O : WS_WCD_O), D, D, (float*)(ws_ + WS_P), D); \
    GRID_BAR(); \
    { FRESH_CTX(cc); unsigned char* ws = KWS(); phase_ln_residual(cc, (bf16_t*)(ws + WS_HB), (const float*)(ws + WS_P), KIN(22) + (L) * D, KIN(23) + (L) * D, nullptr); } \
    GRID_BAR(); \
    GEMM_PHASE(pg8::EpiGU, WS_HB, WS_WGU + (size_t)(L) * 2 * FH * D * 2, 2 * FH, D, (bf16_t*)(ws_ + WS_P), FH); \
    GRID_BAR(); \
    GEMM_PHASE(pg8::EpiF32, WS_P, WS_WDN + (size_t)(L) * D * FH * 2, D, FH, (float*)(ws_ + WS_MIX), D); \
    GRID_BAR(); \
    { FRESH_CTX(cc); unsigned char* ws = KWS(); phase_ln_residual(cc, (bf16_t*)(ws + WS_HB), (const float*)(ws + WS_MIX), KIN(24) + (L) * D, KIN(25) + (L) * D, (L) == 1 ? KOUT() : nullptr); } \
    } while (0)

__global__ void __launch_bounds__(NTHREADS) fwd_megakernel(Params p) {
    extern __shared__ __attribute__((aligned(16))) unsigned char lds_raw[];
    volatile LAS unsigned* ctl = (volatile LAS unsigned*)((LAS unsigned char*)lds_raw + LDSCTL_OFF);
    if (threadIdx.x < 64) ctl[threadIdx.x] = 0u;
    __syncthreads();
    XcdBarrier bar = xcd_barrier_post((unsigned*)(KWS() + WS_CTL) + CW_BAR, ctl + 8);
#define GRID_BAR() do { bar.bar = (unsigned*)(KWS() + WS_CTL) + CW_BAR; xcd_barrier(bar); } while (0)

    { FRESH_CTX(cc); phase_prologue(cc, p.in, KWS()); }
    GRID_BAR();
    GEMM_PHASE(pg8::EpiBf16<0>, WS_HB, WS_WAB_IN, AB_IN, D, (bf16_t*)(ws_ + WS_P), AB_IN, KIN(9), 0, 0, 1.f);
    GRID_BAR();
    { FRESH_CTX(cc); unsigned char* ws = KWS(); phase_attn(cc, (const bf16_t*)(ws + WS_P), KIN(2), KIN(3), KIN(10), (bf16_t*)(ws + WS_MIX), KOUT()); }
    { FRESH_CTX(cc); unsigned char* ws = KWS(); phase_convb(cc, (const bf16_t*)(ws + WS_P), KIN(4), KIN(11), (bf16_t*)(ws + WS_MIX), KOUT()); }
    GRID_BAR();
    LAYER_TAIL(0);
    GRID_BAR();
    GEMM_PHASE(pg8::EpiBf16<0>, WS_HB, WS_WCD_IN, CD_IN, D, (bf16_t*)(ws_ + WS_P), CD_IN, KIN(14), 0, 0, 1.f);
    GRID_BAR();
    { FRESH_CTX(cc); unsigned char* ws = KWS(); phase_hgrn_prep(cc, (const bf16_t*)(ws + WS_P), (const float*)(ws + WS_LB), ws); }
    GRID_BAR();
    if (blockIdx.x < 48) { FRESH_CTX(cc); unsigned char* ws = KWS(); hgrn_chain(cc, (int)blockIdx.x, (const bf16_t*)(ws + WS_P), ws, KIN(6), KIN(20), (bf16_t*)(ws + WS_MIX), KOUT()); }
    if (blockIdx.x >= 16) { FRESH_CTX(cc); unsigned char* ws = KWS(); const float* stc = KIN(5); const float* cw = KIN(15); const float* cb = KIN(16); const float* lg = KIN(17); const float* lbv = KIN(18); float* out = KOUT();
        for (int T = (int)blockIdx.x - 16; T < NTILE64; T += cc.G - 16) convc_tile(cc, T, (const bf16_t*)(ws + WS_P), stc, cw, cb, lg, lbv, (bf16_t*)(ws + WS_MIX), out); }
    GRID_BAR();
    LAYER_TAIL(1);
}

extern "C" void kernel_launch(void* const* d_in, const int* in_sizes, int n_in, void* d_out, int out_size, void* d_ws, size_t ws_size, hipStream_t stream) {
    static int grid = 0;
    if (grid == 0) {
        if (n_in != 28 || ws_size < WS_END) { fprintf(stderr, "kernel_launch: unexpected n_in %d / ws_size %zu (need %zu)\n", n_in, ws_size, (size_t)WS_END); grid = -1; return; }
        int dev = 0, cus = 0, per_cu = 0;
        if (hipGetDevice(&dev) != hipSuccess || hipDeviceGetAttribute(&cus, hipDeviceAttributeMultiprocessorCount, dev) != hipSuccess) { grid = -1; return; }
        if (hipFuncSetAttribute((const void*)fwd_megakernel, hipFuncAttributeMaxDynamicSharedMemorySize, LDS_BYTES) != hipSuccess) { fprintf(stderr, "kernel_launch: hipFuncSetAttribute failed\n"); grid = -1; return; }
        if (hipOccupancyMaxActiveBlocksPerMultiprocessor(&per_cu, (const void*)fwd_megakernel, NTHREADS, LDS_BYTES) != hipSuccess || per_cu < 1) { fprintf(stderr, "kernel_launch: occupancy query says %d blocks per CU\n", per_cu); (void)hipGetLastError(); per_cu = 1; }
        grid = cus;
    }
    if (grid < 0) return;
    (void)hipMemsetAsync((char*)d_ws + WS_CTL, 0, CTL_ZERO_BYTES, stream);
    Params p{};
    for (int i = 0; i < 28; ++i) p.in[i] = (const float*)d_in[i];
    p.out = (float*)d_out; p.ws = (unsigned char*)d_ws;
    hipLaunchKernelGGL(fwd_megakernel, dim3(grid), dim3(NTHREADS), LDS_BYTES, stream, p);
}
```

```cpp
#include <hip/hip_runtime.h>
#include <cstdint>
#include <cstdio>

#define LAS __attribute__((address_space(3)))
typedef unsigned short bf16_t;
typedef short bf16x8 __attribute__((ext_vector_type(8)));
typedef float f32x4 __attribute__((ext_vector_type(4)));
typedef unsigned v4u __attribute__((ext_vector_type(4)));
typedef unsigned v2u __attribute__((ext_vector_type(2)));

constexpr int D = 1024;
constexpr int NB = 4, SEQ = 4096, NMETA = 16, TP = SEQ + NMETA  , PADF = 48, TPP = TP + PADF  ;
constexpr int NS = 8, TS = 64;
constexpr int MP_PROMPT = NB * TPP;
constexpr int MP = MP_PROMPT + NS * TS;
constexpr int NTILE64 = MP / 64;
constexpr int AB_IN = 2304, CD_IN = 3072, FH = 2816;
constexpr float ALPHA = 1.4142135623730951f;
constexpr int NTHREADS = 512, NWAVES = 8;

constexpr size_t O_YP = 0, O_YS = 16777216, O_KAP = 17301504, O_VAP = 17367040, O_CBP = 17432576, O_CCP = 17436672,
                 O_HGP = 17498112, O_KAS = 17760256, O_VAS = 17891328, O_CBS = 18022400, O_CCS = 18030592, O_HGS = 18153472;

constexpr size_t WS_CTL = 0, CTL_ZERO_BYTES = 65536;
constexpr size_t WS_WAB_IN = 1u << 20;
constexpr size_t WS_WAB_O = WS_WAB_IN + (size_t)AB_IN * D * 2;
constexpr size_t WS_WCD_IN = WS_WAB_O + (size_t)D * D * 2;
constexpr size_t WS_WCD_O = WS_WCD_IN + (size_t)CD_IN * D * 2;
constexpr size_t WS_WGU = WS_WCD_O + (size_t)D * D * 2;
constexpr size_t WS_WDN = WS_WGU + (size_t)2 * 2 * FH * D * 2;
constexpr size_t WS_LB = WS_WDN + (size_t)2 * D * FH * 2;
constexpr size_t WS_HB = WS_LB + 4096;
constexpr size_t WS_P = WS_HB + (size_t)MP * D * 2;
constexpr size_t WS_MIX = WS_P + (size_t)MP * CD_IN * 2;
constexpr size_t WS_SPARE = WS_MIX + (size_t)MP * D * 2;
constexpr size_t WS_END = WS_SPARE + (size_t)MP * 512 * 4;
static_assert(WS_END <= 268435456, "workspace map");
constexpr int CW_BAR = 4096;

constexpr int LDS_SCRATCH = 131072, LDSCTL_OFF = LDS_SCRATCH, LDS_BYTES = 147456;

__device__ __forceinline__ bf16_t f2bf(float f) { unsigned u = __float_as_uint(f); u += 0x7fffu + ((u >> 16) & 1u); return (bf16_t)(u >> 16); }
__device__ __forceinline__ unsigned pk2(float lo, float hi) { return (unsigned)f2bf(lo) | ((unsigned)f2bf(hi) << 16); }
__device__ __forceinline__ float bf2f(bf16_t h) { return __uint_as_float(((unsigned)h) << 16); }
__device__ __forceinline__ float sigmoidf_(float x) { return 1.0f / (1.0f + __expf(-x)); }
__device__ __forceinline__ float siluf_(float x) { return x / (1.0f + __expf(-x)); }
__device__ __forceinline__ bf16x8 pack8(f32x4 a, f32x4 b) { v4u w; w.x = pk2(a[0], a[1]); w.y = pk2(a[2], a[3]); w.z = pk2(b[0], b[1]); w.w = pk2(b[2], b[3]); return __builtin_bit_cast(bf16x8, w); }
__device__ __forceinline__ float wave_sum(float v) {
#pragma unroll
    for (int o = 1; o < 64; o <<= 1) v += __shfl_xor(v, o);
    return v;
}

#define XB_TMO      128
#define XB_XCNT(j)  (256  + 64 * (j))
#define XB_XSUB(j)  (1280 + 64 * (j))
#define XB_XGEN(j)  (2304 + 64 * (j))
#define XB_TOP      3328
#define XB_TOPGEN   3392
#define XCD_BAR_WORDS 3456
#define XB_SPIN_CAP (1u << 18)
__device__ __forceinline__ unsigned xb_ld(unsigned* p)              { return __hip_atomic_load(p, __ATOMIC_RELAXED, __HIP_MEMORY_SCOPE_AGENT); }
__device__ __forceinline__ unsigned xb_add(unsigned* p, unsigned v) { return __hip_atomic_fetch_add(p, v, __ATOMIC_RELAXED, __HIP_MEMORY_SCOPE_AGENT); }
__device__ __forceinline__ unsigned xb_xcc_id() { return (unsigned)__builtin_amdgcn_s_getreg((3 << 11) | 20) & 0xFu; }
#define XB_SPIN(cond, bar) do { unsigned _sp = 0; while (cond) { __builtin_amdgcn_s_sleep(1); \
    if ((++_sp & 255u) == 0u) { if (xb_ld(&(bar)[XB_TMO])) break; if (_sp > XB_SPIN_CAP) { atomicAdd(&(bar)[XB_TMO], 1u); break; } } } } while (0)
struct XcdBarrier { unsigned* bar; unsigned x; volatile LAS unsigned* st; };
__device__ __forceinline__ XcdBarrier xcd_barrier_post(unsigned* bar, volatile LAS unsigned* st) {
    XcdBarrier b; b.bar = bar; b.x = xb_xcc_id(); b.st = st;
    if (threadIdx.x == 0) (void)xb_add(&bar[XB_XCNT(b.x)], 1u);
    return b;
}
__device__ __forceinline__ void xcd_barrier_complete(unsigned* bar, unsigned x, unsigned& nloc, unsigned& nx) {
    const unsigned G = gridDim.x * gridDim.y * gridDim.z;
    unsigned sum, cnt, mine, sp = 0u;
    for (;;) {
        sum = 0u; cnt = 0u; mine = 0u;
#pragma unroll
        for (unsigned j = 0; j < 16; ++j) { const unsigned c = xb_ld(&bar[XB_XCNT(j)]); sum += c; cnt += (c > 0u) ? 1u : 0u; mine = (j == x) ? c : mine; }
        if (sum == G) break;
        __builtin_amdgcn_s_sleep(1);
        if ((++sp & 255u) == 0u) { if (xb_ld(&bar[XB_TMO])) break; if (sp > XB_SPIN_CAP) { atomicAdd(&bar[XB_TMO], 1u); break; } }
    }
    nloc = mine > 0u ? mine : 1u; nx = cnt > 0u ? cnt : 1u;
}
__device__ __forceinline__ void xcd_barrier(const XcdBarrier& b) {
    asm volatile("s_waitcnt vmcnt(0)" ::: "memory");
    __syncthreads();
    if (threadIdx.x == 0) {
        unsigned* bar = b.bar;
        __builtin_amdgcn_s_waitcnt(0);
        unsigned nloc = b.st[0], nx = b.st[1];
        if (nloc == 0u) { xcd_barrier_complete(bar, b.x, nloc, nx); b.st[0] = nloc; b.st[1] = nx; }
        const unsigned old = xb_add(&bar[XB_XSUB(b.x)], 1u);
        const unsigned gen = old / nloc;
        if (old + 1u == (gen + 1u) * nloc) {
            __builtin_amdgcn_fence(__ATOMIC_RELEASE, "agent");
            asm volatile("s_waitcnt vmcnt(0)" ::: "memory");
            const unsigned og = xb_add(&bar[XB_TOP], 1u);
            const unsigned tg = og / nx;
            if (og + 1u == (tg + 1u) * nx) xb_add(&bar[XB_TOPGEN], 1u);
            else XB_SPIN(xb_ld(&bar[XB_TOPGEN]) == tg, bar);
            __builtin_amdgcn_fence(__ATOMIC_ACQUIRE, "agent");
            xb_add(&bar[XB_XGEN(b.x)], 1u);
            asm volatile("s_waitcnt vmcnt(0)" ::: "memory");
        } else {
            XB_SPIN(xb_ld(&bar[XB_XGEN(b.x)]) == gen, bar);
            __builtin_amdgcn_fence(__ATOMIC_ACQUIRE, "agent");
            asm volatile("s_waitcnt vmcnt(0)" ::: "memory");
        }
    }
    __syncthreads();
}

namespace pg8 {
#define PG8_LAS __attribute__((address_space(3)))
typedef unsigned short bf16_t;
typedef short bf16x8 __attribute__((ext_vector_type(8)));
typedef float f32x4 __attribute__((ext_vector_type(4)));
typedef unsigned u32x4 __attribute__((ext_vector_type(4)));
constexpr int BM = 256, BK = 64, HALF = 128, HTB = HALF * BK * 2  , STAGE_BYTES = 8 * HTB, NXCD = 8, WGM = 8;

__host__ __device__ __forceinline__ int lds_byte(int r, int c) { const int st = (r >> 4) * 2 + (c >> 5), rr = r & 15, cc = c & 31, ob = rr * 64 + cc * 2; return st * 1024 + (ob ^ (((ob >> 9) & 1) << 5)); }
__host__ __device__ __forceinline__ void stage_rc(int b, int& R, int& C) { const int st = b / 1024, sb = b % 1024, swz = sb ^ (((sb >> 9) & 1) << 5); R = (st >> 1) * 16 + swz / 64; C = (st & 1) * 32 + (swz % 64) / 2; }
__host__ __device__ __forceinline__ int perm32(int rho) { const int n = rho >> 4, i = rho & 15; return 8 * (i >> 2) + 4 * n + (i & 3); }

struct Unit { int pm, pn; };
struct Gemm { const bf16_t* A; const bf16_t* Bt; int M, N, K; };

struct StaticOrder {
    int nM, nN, nwg, G, c;
    __host__ __device__ void init(int M, int N, int G_, int c_) { nM = M / BM; nN = N / BM; nwg = nM * nN; G = G_; c = c_; }
    __host__ __device__ bool next(int i, Unit& u) const {
        const long L = (long)i * G + c; if (L >= nwg) return false;
        int wgid = (int)L; { const int q = nwg / NXCD, r = nwg % NXCD, xcd = wgid % NXCD, off = wgid / NXCD; wgid = (xcd < r ? xcd * (q + 1) : r * (q + 1) + (xcd - r) * q) + off; }
        const int nig = WGM * nN, gid = wgid / nig, fm = gid * WGM, gsz = (nM - fm) < WGM ? (nM - fm) : WGM;
        u.pm = fm + ((wgid % nig) % gsz); u.pn = (wgid % nig) / gsz; return true;
    }
    __device__ __forceinline__ void a_ready(const Unit&) const {}
    __device__ __forceinline__ void done(const Unit&) const {}
};

__device__ __forceinline__ unsigned cvt_pk_bf16(float lo, float hi) { unsigned r; asm volatile("v_cvt_pk_bf16_f32 %0, %1, %2" : "=v"(r) : "v"(lo), "v"(hi)); return r; }
template <int ACT  > struct EpiBf16 {
    static constexpr bool PERM = true, AFTER_DRAIN = false; static_assert(ACT == 0, "EpiBf16: ACT is 0 (none)");
    bf16_t* O; int ldc; const float* bias; int split_cols; size_t split_stride; float scale0;
    __device__ __forceinline__ void operator()(const f32x4 (&acc)[2][2][4][2], const Unit& u, int wr, int wc, int fr, int fq) const {
        const int row0 = u.pm * BM + wr * 64 + fr; int colt = u.pn * BM; bf16_t* base = O;
        float sc = 1.f; if (split_cols) { const int t = colt / split_cols; base += (size_t)t * split_stride; colt -= t * split_cols; if (t == 0) sc = scale0; }
        const int col0 = colt + wc * 32 + 8 * fq, bcol0 = u.pn * BM + wc * 32 + 8 * fq;
        f32x4 bv[2][2];
#pragma unroll
        for (int bj = 0; bj < 2; ++bj)
#pragma unroll
            for (int n = 0; n < 2; ++n) bv[bj][n] = bias ? *(const f32x4*)(bias + bcol0 + bj * HALF + 4 * n) : (f32x4){0.f, 0.f, 0.f, 0.f};
#pragma unroll
        for (int ai = 0; ai < 2; ++ai)
#pragma unroll
            for (int m = 0; m < 4; ++m) { bf16_t* rowp = base + (size_t)(row0 + ai * HALF + m * 16) * ldc + col0;
#pragma unroll
                for (int bj = 0; bj < 2; ++bj) { f32x4 v0 = acc[ai][bj][m][0] + bv[bj][0], v1 = acc[ai][bj][m][1] + bv[bj][1];
                    v0 = v0 * sc; v1 = v1 * sc; u32x4 w; w.x = cvt_pk_bf16(v0[0], v0[1]); w.y = cvt_pk_bf16(v0[2], v0[3]); w.z = cvt_pk_bf16(v1[0], v1[1]); w.w = cvt_pk_bf16(v1[2], v1[3]);
                    *(u32x4*)(rowp + bj * HALF) = w; } }
    }
};

struct EpiF32 {
    static constexpr bool PERM = false, AFTER_DRAIN = false;
    float* C; int ldc;
    __device__ __forceinline__ void operator()(const f32x4 (&acc)[2][2][4][2], const Unit& u, int wr, int wc, int fr, int fq) const {
        const int row0 = u.pm * BM + wr * 64 + fr, col0 = u.pn * BM + wc * 32 + 4 * fq;
#pragma unroll
        for (int ai = 0; ai < 2; ++ai)
#pragma unroll
            for (int m = 0; m < 4; ++m) { float* rowp = C + (size_t)(row0 + ai * HALF + m * 16) * ldc + col0;
#pragma unroll
                for (int bj = 0; bj < 2; ++bj)
#pragma unroll
                    for (int n = 0; n < 2; ++n) *(f32x4*)(rowp + bj * HALF + n * 16) = acc[ai][bj][m][n]; }
    }
};
struct EpiGU {
    static constexpr bool PERM = true, AFTER_DRAIN = false;
    bf16_t* O; int ldc;
    __device__ __forceinline__ void operator()(const f32x4 (&acc)[2][2][4][2], const Unit& u, int wr, int wc, int fr, int fq) const {
        const int row0 = u.pm * BM + wr * 64 + fr, col0 = u.pn * HALF + wc * 32 + 8 * fq;
#pragma unroll
        for (int ai = 0; ai < 2; ++ai)
#pragma unroll
            for (int m = 0; m < 4; ++m) { bf16_t* rowp = O + (size_t)(row0 + ai * HALF + m * 16) * ldc + col0;
                f32x4 h0, h1;
#pragma unroll
                for (int r = 0; r < 4; ++r) { const float g0 = acc[ai][0][m][0][r], g1 = acc[ai][0][m][1][r];
                    h0[r] = g0 * __builtin_amdgcn_rcpf(1.0f + __expf(-g0)) * acc[ai][1][m][0][r]; h1[r] = g1 * __builtin_amdgcn_rcpf(1.0f + __expf(-g1)) * acc[ai][1][m][1][r]; }
                u32x4 w; w.x = cvt_pk_bf16(h0[0], h0[1]); w.y = cvt_pk_bf16(h0[2], h0[3]); w.z = cvt_pk_bf16(h1[0], h1[1]); w.w = cvt_pk_bf16(h1[2], h1[3]);
                *(u32x4*)rowp = w; }
    }
};

template <class Epi, class Sched, bool ALIGN_EPI = false, bool SP2 = false>
__device__ __forceinline__ void gemm_phase(PG8_LAS unsigned char* lds, const Gemm g, const Sched& S, const Epi& E) {
    const int tid = threadIdx.x, wid = __builtin_amdgcn_readfirstlane(tid >> 6), lane = tid & 63, wr = wid >> 2, wc = wid & 3, fr = lane & 15, fq = lane >> 4;
    const int K = g.K, nt = K / BK;
    unsigned voffA[2], voffB[2];
#pragma unroll
    for (int i = 0; i < 2; ++i) { int R, C; stage_rc(tid * 16 + i * 8192, R, C); const int Rb = Epi::PERM ? ((R & ~31) + perm32(R & 31)) : R;
        voffA[i] = (unsigned)(R * K + C) * 2u; voffB[i] = (unsigned)(Rb * K + C) * 2u; }
    const size_t kstep = (size_t)(BK * 2);
    const size_t hstep = (size_t)HALF * K * 2;
    const size_t tstep = 2 * hstep;
    const unsigned ldsw = (unsigned)wid * 1024u;
    const int aoff = lds_byte(wr * 64 + fr, fq * 8), boff = lds_byte(wc * 32 + fr, fq * 8);
#define PG8_SA(b, h) (((b) * 2 + (h)) * HTB)
#define PG8_SB(b, h) ((4 + (b) * 2 + (h)) * HTB)
#define PG8_STAGE(bufoff, gbase, voff) do { _Pragma("unroll") for (int _i = 0; _i < 2; ++_i) \
        __builtin_amdgcn_global_load_lds((const unsigned*)((const char*)(gbase) + (voff)[_i]), (PG8_LAS unsigned*)(lds + (bufoff) + ldsw + _i * 8192), 16, 0, 0); } while (0)
#define PG8_LDA(dst, b, h) do { _Pragma("unroll") for (int m = 0; m < 4; ++m) _Pragma("unroll") for (int k = 0; k < 2; ++k) dst[m][k] = *(const PG8_LAS bf16x8*)(lds + PG8_SA(b, h) + aoff + m * 2048 + k * 1024); } while (0)
#define PG8_LDB(dst, b, h) do { _Pragma("unroll") for (int n = 0; n < 2; ++n) _Pragma("unroll") for (int k = 0; k < 2; ++k) dst[n][k] = *(const PG8_LAS bf16x8*)(lds + PG8_SB(b, h) + boff + n * 2048 + k * 1024); } while (0)
#define PG8_MMA(ai, bj, At, Bt) do { __builtin_amdgcn_s_setprio(1); _Pragma("unroll") for (int m = 0; m < 4; ++m) _Pragma("unroll") for (int n = 0; n < 2; ++n) _Pragma("unroll") for (int k = 0; k < 2; ++k) \
        acc[ai][bj][m][n] = __builtin_amdgcn_mfma_f32_16x16x32_bf16(Bt[n][k], At[m][k], acc[ai][bj][m][n], 0, 0, 0); __builtin_amdgcn_s_setprio(0); } while (0)
#define PG8_WAIT_V(n) asm volatile("s_waitcnt vmcnt(" #n ")" ::: "memory")
#define PG8_WAIT_L(n) asm volatile("s_waitcnt lgkmcnt(" #n ")" ::: "memory")
#define PG8_BAR __builtin_amdgcn_s_barrier()
#define PG8_SCHED __builtin_amdgcn_sched_barrier(0)
    Unit cur, nxt; int ui = 0;
    if (!S.next(0, cur)) return;
    f32x4 acc[2][2][4][2];
#pragma unroll
    for (int a = 0; a < 2; ++a)
#pragma unroll
        for (int b = 0; b < 2; ++b)
#pragma unroll
            for (int m = 0; m < 4; ++m)
#pragma unroll
                for (int n = 0; n < 2; ++n) acc[a][b][m][n] = (f32x4){0.f, 0.f, 0.f, 0.f};
    bf16x8 At[4][2], B0[2][2], B1[2][2];
    const char* cA = (const char*)g.A + (size_t)cur.pm * tstep; const char* cB = (const char*)g.Bt + (size_t)cur.pn * tstep;
    S.a_ready(cur);
    if constexpr (SP2) {
        PG8_STAGE(PG8_SB(0, 0), cB, voffB); PG8_STAGE(PG8_SB(0, 1), cB + hstep, voffB); PG8_STAGE(PG8_SA(0, 0), cA, voffA); PG8_STAGE(PG8_SA(0, 1), cA + hstep, voffA);
        if (wr == 1) PG8_BAR;
        PG8_WAIT_V(2); PG8_BAR;
        PG8_STAGE(PG8_SB(1, 0), cB + kstep, voffB); PG8_STAGE(PG8_SA(1, 0), cA + kstep, voffA); PG8_STAGE(PG8_SB(1, 1), cB + hstep + kstep, voffB);
        PG8_WAIT_V(6); PG8_BAR;
    } else {
        PG8_STAGE(PG8_SB(0, 0), cB, voffB); PG8_STAGE(PG8_SA(0, 0), cA, voffA); PG8_STAGE(PG8_SB(0, 1), cB + hstep, voffB); PG8_STAGE(PG8_SA(0, 1), cA + hstep, voffA);
        if (wr == 1) PG8_BAR;
        PG8_WAIT_V(4); PG8_BAR;
        PG8_STAGE(PG8_SB(1, 0), cB + kstep, voffB); PG8_STAGE(PG8_SA(1, 0), cA + kstep, voffA); PG8_STAGE(PG8_SB(1, 1), cB + hstep + kstep, voffB);
        PG8_WAIT_V(6); PG8_BAR;
    }
    for (;;) {
        const bool has_next = S.next(ui + 1, nxt);
        const char* nA = has_next ? (const char*)g.A + (size_t)nxt.pm * tstep : cA; const char* nB = has_next ? (const char*)g.Bt + (size_t)nxt.pn * tstep : cB;
        for (int t = 0; t < nt; t += 2) {
            const bool last = (t == nt - 2);
            const char* a1 = cA + (size_t)(t + 1) * kstep;
            const char* a2 = last ? nA : cA + (size_t)(t + 2) * kstep; const char* b2 = last ? nB : cB + (size_t)(t + 2) * kstep;
            const char* a3 = a2 + kstep; const char* b3 = b2 + kstep;
            if (last && has_next) S.a_ready(nxt);
            if constexpr (SP2) {
            PG8_LDB(B0, 0, 0); PG8_LDB(B1, 0, 1); PG8_SCHED; PG8_LDA(At, 0, 0); PG8_STAGE(PG8_SA(1, 1), a1 + hstep, voffA);
            PG8_WAIT_V(8); PG8_WAIT_L(0); PG8_BAR; PG8_MMA(0, 0, At, B0); PG8_MMA(0, 1, At, B1); PG8_BAR; PG8_SCHED;
            PG8_LDA(At, 0, 1); PG8_STAGE(PG8_SB(0, 0), b2, voffB); PG8_STAGE(PG8_SB(0, 1), b2 + hstep, voffB); PG8_STAGE(PG8_SA(0, 0), a2, voffA);
            PG8_WAIT_V(8); PG8_WAIT_L(0); PG8_BAR; PG8_MMA(1, 0, At, B0); PG8_MMA(1, 1, At, B1); PG8_BAR; PG8_SCHED;
            PG8_LDB(B0, 1, 0); PG8_LDB(B1, 1, 1); PG8_SCHED; PG8_LDA(At, 1, 0); PG8_STAGE(PG8_SA(0, 1), a2 + hstep, voffA);
            PG8_WAIT_V(8); PG8_WAIT_L(0); PG8_BAR; PG8_MMA(0, 0, At, B0); PG8_MMA(0, 1, At, B1); PG8_BAR; PG8_SCHED;
            PG8_LDA(At, 1, 1); PG8_STAGE(PG8_SB(1, 0), b3, voffB); PG8_STAGE(PG8_SB(1, 1), b3 + hstep, voffB); PG8_STAGE(PG8_SA(1, 0), a3, voffA);
            PG8_WAIT_V(8); PG8_WAIT_L(0); PG8_BAR; PG8_MMA(1, 0, At, B0); PG8_MMA(1, 1, At, B1); PG8_BAR; PG8_SCHED;
            } else {
            PG8_LDB(B0, 0, 0); PG8_SCHED; PG8_LDA(At, 0, 0); PG8_STAGE(PG8_SA(1, 1), a1 + hstep, voffA);
            PG8_WAIT_L(8); PG8_BAR; PG8_WAIT_L(0); PG8_MMA(0, 0, At, B0); PG8_BAR; PG8_SCHED;
            PG8_LDB(B1, 0, 1); PG8_STAGE(PG8_SB(0, 0), b2, voffB);
            PG8_BAR; PG8_WAIT_L(0); PG8_MMA(0, 1, At, B1); PG8_BAR;
            PG8_LDA(At, 0, 1); PG8_STAGE(PG8_SA(0, 0), a2, voffA);
            PG8_BAR; PG8_WAIT_L(0); PG8_MMA(1, 0, At, B0); PG8_BAR; PG8_SCHED;
            PG8_STAGE(PG8_SB(0, 1), b2 + hstep, voffB);
            PG8_WAIT_V(6); PG8_BAR; PG8_MMA(1, 1, At, B1); PG8_BAR;
            PG8_LDB(B0, 1, 0); PG8_SCHED; PG8_LDA(At, 1, 0); PG8_STAGE(PG8_SA(0, 1), a2 + hstep, voffA);
            PG8_WAIT_L(8); PG8_BAR; PG8_WAIT_L(0); PG8_MMA(0, 0, At, B0); PG8_BAR; PG8_SCHED;
            PG8_LDB(B1, 1, 1); PG8_STAGE(PG8_SB(1, 0), b3, voffB);
            PG8_BAR; PG8_WAIT_L(0); PG8_MMA(0, 1, At, B1); PG8_BAR;
            PG8_LDA(At, 1, 1); PG8_STAGE(PG8_SA(1, 0), a3, voffA);
            PG8_BAR; PG8_WAIT_L(0); PG8_MMA(1, 0, At, B0); PG8_BAR; PG8_SCHED;
            PG8_STAGE(PG8_SB(1, 1), b3 + hstep, voffB);
            PG8_WAIT_V(6); PG8_BAR; PG8_MMA(1, 1, At, B1); PG8_BAR;
            }
        }
        if constexpr (ALIGN_EPI) { if (wr == 0) PG8_BAR; }
        if constexpr (!Epi::AFTER_DRAIN) { E(acc, cur, wr, wc, fr, fq); S.done(cur); }
        if (!has_next) break;
#pragma unroll
        for (int a = 0; a < 2; ++a)
#pragma unroll
            for (int b = 0; b < 2; ++b)
#pragma unroll
                for (int m = 0; m < 4; ++m)
#pragma unroll
                    for (int n = 0; n < 2; ++n) acc[a][b][m][n] = (f32x4){0.f, 0.f, 0.f, 0.f};
        cur = nxt; cA = nA; cB = nB; ++ui;
        if constexpr (ALIGN_EPI) { if (wr == 1) PG8_BAR; }
    }
    PG8_WAIT_V(0);
    if constexpr (!ALIGN_EPI) { if (wr == 0) PG8_BAR; }
    PG8_BAR;
    if constexpr (Epi::AFTER_DRAIN) { E.fused(acc, cur, wr, wc, fr, fq, lds, wid, lane); S.done(cur); }
#undef PG8_SA
#undef PG8_SB
#undef PG8_STAGE
#undef PG8_LDA
#undef PG8_LDB
#undef PG8_MMA
#undef PG8_WAIT_V
#undef PG8_WAIT_L
#undef PG8_BAR
#undef PG8_SCHED
}
}


struct Ctx { LAS unsigned char* lds; int tid, lane, wave, G, gw, NGW; };

template <bool GU>
__device__ __forceinline__ void transpose_item(const float* __restrict__ W, int K, int N, bf16_t* __restrict__ WT, LAS float* scr, int item, int lane) {
    const int nblk = N / 32, kb = item / nblk, nb = item % nblk, k0 = 64 * kb, n0 = 32 * nb;
#pragma unroll 8
    for (int i = 0; i < 32; ++i) { const int kk = 2 * i + (lane >> 5); scr[kk * 33 + (lane & 31)] = W[(size_t)(k0 + kk) * N + n0 + (lane & 31)]; }
    asm volatile("s_waitcnt lgkmcnt(0)" ::: "memory");
    const int c = lane & 7;
#pragma unroll
    for (int j = 0; j < 4; ++j) { const int n = (lane >> 3) + 8 * j; const LAS float* s = scr + (8 * c) * 33 + n;
        v4u o; o.x = pk2(s[0 * 33], s[1 * 33]); o.y = pk2(s[2 * 33], s[3 * 33]); o.z = pk2(s[4 * 33], s[5 * 33]); o.w = pk2(s[6 * 33], s[7 * 33]);
        const int nn = n0 + n, orow = GU ? (nn < FH ? (nn >> 7) * 256 + (nn & 127) : ((nn - FH) >> 7) * 256 + 128 + ((nn - FH) & 127)) : nn;
        *(v4u*)(WT + (size_t)orow * K + k0 + 8 * c) = o; }
    asm volatile("s_waitcnt lgkmcnt(0)" ::: "memory");
}
__device__ __forceinline__ void embed_row(const float* __restrict__ xp, const float* __restrict__ xs, const float* __restrict__ meta, bf16_t* __restrict__ Hb, int row, int lane) {
    const float* src = nullptr;
    if (row < MP_PROMPT) { const int b = row / TPP, p = row % TPP; if (p >= PADF) { const int i = p - PADF; src = i < NMETA ? meta + (size_t)i * D : xp + ((size_t)b * SEQ + (i - NMETA)) * D; } }
    else src = xs + (size_t)(row - MP_PROMPT) * D;
    v2u* o = (v2u*)(Hb + (size_t)row * D) + lane;
#pragma unroll
    for (int j = 0; j < 4; ++j) { v2u w = {0u, 0u}; if (src) { const f32x4 v = ((const f32x4*)src)[lane + 64 * j]; w.x = pk2(v[0], v[1]); w.y = pk2(v[2], v[3]); } o[64 * j] = w; }
}
#define in_(i) KIN_FWD(i)
__device__ __forceinline__ unsigned long long karg_raw(int i);
#define KIN_FWD(i) ((const float*)(const __attribute__((address_space(1))) float*)karg_raw(i))
__device__ __forceinline__ void phase_prologue(const Ctx& c, const float* const*, unsigned char* ws) {
    LAS float* scr = (LAS float*)(c.lds + c.wave * 16384);
    constexpr int I_ABI = 16 * (AB_IN / 32), I_O = 16 * 32, I_CDI = 16 * (CD_IN / 32), I_GU = 16 * (2 * FH / 32), I_DN = (FH / 64) * 32;
    constexpr int NITEMS = I_ABI + I_O + I_CDI + I_O + 2 * I_GU + 2 * I_DN;
    for (int it = c.gw; it < NITEMS; it += c.NGW) {
        int r = it;
        if (r < I_ABI) { transpose_item<false>(in_(8), D, AB_IN, (bf16_t*)(ws + WS_WAB_IN), scr, r, c.lane); continue; } r -= I_ABI;
        if (r < I_O) { transpose_item<false>(in_(12), D, D, (bf16_t*)(ws + WS_WAB_O), scr, r, c.lane); continue; } r -= I_O;
        if (r < I_CDI) { transpose_item<false>(in_(13), D, CD_IN, (bf16_t*)(ws + WS_WCD_IN), scr, r, c.lane); continue; } r -= I_CDI;
        if (r < I_O) { transpose_item<false>(in_(21), D, D, (bf16_t*)(ws + WS_WCD_O), scr, r, c.lane); continue; } r -= I_O;
        if (r < 2 * I_GU) { const int l = r / I_GU; transpose_item<true>(in_(26) + (size_t)l * D * 2 * FH, D, 2 * FH, (bf16_t*)(ws + WS_WGU) + (size_t)l * 2 * FH * D, scr, r % I_GU, c.lane); continue; } r -= 2 * I_GU;
        { const int l = r / I_DN; transpose_item<false>(in_(27) + (size_t)l * FH * D, FH, D, (bf16_t*)(ws + WS_WDN) + (size_t)l * D * FH, scr, r % I_DN, c.lane); }
    }
    for (int row = c.gw; row < MP; row += c.NGW) embed_row(in_(0), in_(1), in_(7), (bf16_t*)(ws + WS_HB), row, c.lane);
    if (blockIdx.x == 0) { const int ch = c.tid; const float l0 = in_(19)[ch], l1 = in_(19)[512 + ch]; const float m = fmaxf(l0, l1); const float e0 = expf(l0 - m), e1 = expf(l1 - m); ((float*)(ws + WS_LB))[ch] = e1 / (e0 + e1); }
}

__device__ __forceinline__ void phase_ln_residual(const Ctx& c, bf16_t* __restrict__ Hb, const float* __restrict__ mix, const float* __restrict__ g, const float* __restrict__ b, float* __restrict__ outf) {
    for (int row = c.gw; row < MP; row += c.NGW) {
        f32x4 y[4]; float s = 0.f;
        const v2u* hp = (const v2u*)(Hb + (size_t)row * D) + c.lane; const f32x4* mp = (const f32x4*)(mix + (size_t)row * D) + c.lane;
#pragma unroll
        for (int j = 0; j < 4; ++j) { const v2u hw = hp[64 * j]; const f32x4 mv = mp[64 * j];
            y[j][0] = ALPHA * __uint_as_float(hw.x << 16) + mv[0]; y[j][1] = ALPHA * __uint_as_float(hw.x & 0xffff0000u) + mv[1];
            y[j][2] = ALPHA * __uint_as_float(hw.y << 16) + mv[2]; y[j][3] = ALPHA * __uint_as_float(hw.y & 0xffff0000u) + mv[3];
            s += (y[j][0] + y[j][1]) + (y[j][2] + y[j][3]); }
        const float mu = wave_sum(s) * (1.0f / D); float q = 0.f;
#pragma unroll
        for (int j = 0; j < 4; ++j) { y[j] = y[j] - mu; q += (y[j][0] * y[j][0] + y[j][1] * y[j][1]) + (y[j][2] * y[j][2] + y[j][3] * y[j][3]); }
        const float rstd = rsqrtf(wave_sum(q) * (1.0f / D) + 1e-5f);
        float* op = nullptr;
        if (outf) { if (row < MP_PROMPT) { const int bb = row / TPP, p = row % TPP; if (p >= PADF + NMETA) op = outf + O_YP + ((size_t)bb * SEQ + (p - PADF - NMETA)) * D; } else op = outf + O_YS + (size_t)(row - MP_PROMPT) * D; }
        v2u* ho = (v2u*)(Hb + (size_t)row * D) + c.lane;
#pragma unroll
        for (int j = 0; j < 4; ++j) { const f32x4 gv = ((const f32x4*)g)[c.lane + 64 * j], bv = ((const f32x4*)b)[c.lane + 64 * j]; const f32x4 v = y[j] * rstd * gv + bv;
            v2u w; w.x = pk2(v[0], v[1]); w.y = pk2(v[2], v[3]); ho[64 * j] = w; if (op) ((f32x4*)op)[c.lane + 64 * j] = v; }
    }
}

__device__ __forceinline__ int kperm32(int kl) { return kl < 16 ? (kl >> 2) * 8 + (kl & 3) : ((kl - 16) >> 2) * 8 + 4 + (kl & 3); }
__device__ __forceinline__ void phase_attn(const Ctx& c, const bf16_t* __restrict__ P0, const float* __restrict__ ck, const float* __restrict__ cv, const float* __restrict__ sinks, bf16_t* __restrict__ MIX, float* __restrict__ out) {
    LAS bf16_t* Ks = (LAS bf16_t*)c.lds;
    LAS bf16_t* VTs = Ks + 192 * 72;
    const int w = c.wave;
    for (int u = blockIdx.x; u < NTILE64 * 2; u += c.G) {
        int tid = c.tid; asm volatile("" : "+v"(tid));
        const int lane = tid & 63, fr = lane & 15, fq = lane >> 4;
        const int T = u >> 1, kvh = u & 1;
        const bool samp = T >= NB * 65; const int sq = T - NB * 65, cc = samp ? 0 : T % 65, bb = samp ? 0 : T / 65;
        const int row0 = T * 64;
        __syncthreads();
#pragma unroll 1
        for (int i = 0; i < 3; ++i) {
            const int cid = tid + 512 * i, j = cid >> 3, ch = cid & 7;
            v4u kw = {0u, 0u, 0u, 0u}, vw = {0u, 0u, 0u, 0u};
            if (samp && j < 128) {
                const float* kp = ck + (((size_t)sq * 128 + j) * 2 + kvh) * 64 + ch * 8; const float* vp = cv + (((size_t)sq * 128 + j) * 2 + kvh) * 64 + ch * 8;
                const f32x4 k0 = *(const f32x4*)kp, k1 = *(const f32x4*)(kp + 4), v0 = *(const f32x4*)vp, v1 = *(const f32x4*)(vp + 4);
                kw = (v4u){pk2(k0[0], k0[1]), pk2(k0[2], k0[3]), pk2(k1[0], k1[1]), pk2(k1[2], k1[3])}; vw = (v4u){pk2(v0[0], v0[1]), pk2(v0[2], v0[3]), pk2(v1[0], v1[1]), pk2(v1[2], v1[3])};
                if (j >= 64) { float* ko = out + O_KAS + (((size_t)sq * 128 + (j - 64)) * 2 + kvh) * 64 + ch * 8; float* vo = out + O_VAS + (((size_t)sq * 128 + (j - 64)) * 2 + kvh) * 64 + ch * 8;
                    *(f32x4*)ko = k0; *(f32x4*)(ko + 4) = k1; *(f32x4*)vo = v0; *(f32x4*)(vo + 4) = v1; }
            } else if (samp || (cc - 2) * 64 + j >= PADF) {
                const size_t r = (size_t)(row0 - 128 + j) * AB_IN + kvh * 64 + ch * 8;
                kw = *(const v4u*)(P0 + r + 512); vw = *(const v4u*)(P0 + r + 640);
                if (j >= 128 && (samp || cc >= 63)) {
                    const size_t orow = samp ? ((size_t)sq * 128 + 64 + (j - 128)) : ((size_t)bb * 128 + (cc - 63) * 64 + (j - 128));
                    float* ko = out + (samp ? O_KAS : O_KAP) + (orow * 2 + kvh) * 64 + ch * 8; float* vo = out + (samp ? O_VAS : O_VAP) + (orow * 2 + kvh) * 64 + ch * 8;
                    *(f32x4*)ko = (f32x4){__uint_as_float(kw.x << 16), __uint_as_float(kw.x & 0xffff0000u), __uint_as_float(kw.y << 16), __uint_as_float(kw.y & 0xffff0000u)};
                    *(f32x4*)(ko + 4) = (f32x4){__uint_as_float(kw.z << 16), __uint_as_float(kw.z & 0xffff0000u), __uint_as_float(kw.w << 16), __uint_as_float(kw.w & 0xffff0000u)};
                    *(f32x4*)vo = (f32x4){__uint_as_float(vw.x << 16), __uint_as_float(vw.x & 0xffff0000u), __uint_as_float(vw.y << 16), __uint_as_float(vw.y & 0xffff0000u)};
                    *(f32x4*)(vo + 4) = (f32x4){__uint_as_float(vw.z << 16), __uint_as_float(vw.z & 0xffff0000u), __uint_as_float(vw.w << 16), __uint_as_float(vw.w & 0xffff0000u)};
                }
            }
            *(LAS v4u*)(Ks + j * 72 + ch * 8) = kw;
            const int pos = (j & ~31) + kperm32(j & 31); LAS bf16_t* vt = VTs + (ch * 8) * 200 + pos;
            vt[0 * 200] = (bf16_t)(vw.x & 0xffffu); vt[1 * 200] = (bf16_t)(vw.x >> 16); vt[2 * 200] = (bf16_t)(vw.y & 0xffffu); vt[3 * 200] = (bf16_t)(vw.y >> 16);
            vt[4 * 200] = (bf16_t)(vw.z & 0xffffu); vt[5 * 200] = (bf16_t)(vw.z >> 16); vt[6 * 200] = (bf16_t)(vw.w & 0xffffu); vt[7 * 200] = (bf16_t)(vw.w >> 16);
        }
        __syncthreads();
        const int g = w >> 1, h = kvh * 4 + g, qh = w & 1;
        const float slope = exp2f(-(float)(h + 1)), sink = sinks[h];
        const int jmin = samp ? 0 : ((cc - 2) * 64 >= PADF ? 0 : PADF - (cc - 2) * 64);
#pragma unroll 1
        for (int qt = 0; qt < 2; ++qt) {
            const int t = 32 * qh + 16 * qt + fr;
            bf16x8 qf[2];
#pragma unroll
            for (int ds = 0; ds < 2; ++ds) qf[ds] = *(const bf16x8*)(P0 + (size_t)(row0 + t) * AB_IN + h * 64 + 32 * ds + 8 * fq);
            f32x4 sacc[12];
#pragma unroll
            for (int kt = 0; kt < 12; ++kt) { sacc[kt] = (f32x4){0.f, 0.f, 0.f, 0.f};
#pragma unroll
                for (int ds = 0; ds < 2; ++ds) { const bf16x8 a = *(const LAS bf16x8*)(Ks + (16 * kt + fr) * 72 + 32 * ds + 8 * fq); sacc[kt] = __builtin_amdgcn_mfma_f32_16x16x32_bf16(a, qf[ds], sacc[kt], 0, 0, 0); }
                if ((kt & 3) == 3) __builtin_amdgcn_sched_barrier(0); }
            float m = -1e30f;
#pragma unroll
            for (int kt = 0; kt < 12; ++kt)
#pragma unroll
                for (int r = 0; r < 4; ++r) { const int j = 16 * kt + 4 * fq + r; float sc = sacc[kt][r] * 0.125f - slope * fabsf((float)(128 + t - j)); sc = j >= jmin ? sc : -1e30f; sacc[kt][r] = sc; m = fmaxf(m, sc); }
            m = fmaxf(m, __shfl_xor(m, 16)); m = fmaxf(m, __shfl_xor(m, 32)); m = fmaxf(m, sink);
            float l = 0.f;
#pragma unroll
            for (int kt = 0; kt < 12; ++kt)
#pragma unroll
                for (int r = 0; r < 4; ++r) { const float p = __expf(sacc[kt][r] - m); sacc[kt][r] = p; l += p; }
            l += __shfl_xor(l, 16); l += __shfl_xor(l, 32); l += __expf(sink - m);
            const float inv = 1.0f / l;
            f32x4 oacc[4];
#pragma unroll
            for (int dt = 0; dt < 4; ++dt) oacc[dt] = (f32x4){0.f, 0.f, 0.f, 0.f};
#pragma unroll
            for (int ks = 0; ks < 6; ++ks) { const bf16x8 pb = pack8(sacc[2 * ks], sacc[2 * ks + 1]);
#pragma unroll
                for (int dt = 0; dt < 4; ++dt) { const bf16x8 a = *(const LAS bf16x8*)(VTs + (16 * dt + fr) * 200 + 32 * ks + 8 * fq); oacc[dt] = __builtin_amdgcn_mfma_f32_16x16x32_bf16(a, pb, oacc[dt], 0, 0, 0); }
                if (ks & 1) __builtin_amdgcn_sched_barrier(0); }
            bf16_t* op = MIX + (size_t)(row0 + t) * D + h * 64 + 4 * fq;
#pragma unroll
            for (int dt = 0; dt < 4; ++dt) { v2u o; o.x = pk2(oacc[dt][0] * inv, oacc[dt][1] * inv); o.y = pk2(oacc[dt][2] * inv, oacc[dt][3] * inv); *(v2u*)(op + 16 * dt) = o; }
        }
    }
    __syncthreads();
}

__device__ __forceinline__ void phase_convb(const Ctx& c, const bf16_t* __restrict__ P0, const float* __restrict__ stb, const float* __restrict__ w, bf16_t* __restrict__ MIX, float* __restrict__ out) {
    for (int it = blockIdx.x * NTHREADS + c.tid; it < MP * 64; it += c.G * NTHREADS) {
        const int row = it >> 6, ch = (it & 63) * 8;
        const bool samp = row >= MP_PROMPT; const int pos = samp ? (row - MP_PROMPT) % TS : row % TPP - PADF, sq = samp ? (row - MP_PROMPT) / TS : row / TPP;
        float u[3][8];
#pragma unroll
        for (int back = 0; back < 3; ++back) {
            if (pos - back >= 0) { const size_t r = (size_t)(row - back) * AB_IN + ch; const v4u cg = *(const v4u*)(P0 + r + 1280), hb = *(const v4u*)(P0 + r + 1792);
                u[back][0] = __uint_as_float(cg.x << 16) * __uint_as_float(hb.x << 16); u[back][1] = __uint_as_float(cg.x & 0xffff0000u) * __uint_as_float(hb.x & 0xffff0000u);
                u[back][2] = __uint_as_float(cg.y << 16) * __uint_as_float(hb.y << 16); u[back][3] = __uint_as_float(cg.y & 0xffff0000u) * __uint_as_float(hb.y & 0xffff0000u);
                u[back][4] = __uint_as_float(cg.z << 16) * __uint_as_float(hb.z << 16); u[back][5] = __uint_as_float(cg.z & 0xffff0000u) * __uint_as_float(hb.z & 0xffff0000u);
                u[back][6] = __uint_as_float(cg.w << 16) * __uint_as_float(hb.w << 16); u[back][7] = __uint_as_float(cg.w & 0xffff0000u) * __uint_as_float(hb.w & 0xffff0000u); }
            else if (samp) { const float* sp = stb + ((size_t)sq * 2 + (2 + pos - back)) * 512 + ch;
#pragma unroll
                for (int i = 0; i < 8; ++i) u[back][i] = sp[i]; }
            else {
#pragma unroll
                for (int i = 0; i < 8; ++i) u[back][i] = 0.f; }
        }
        const v4u bg = *(const v4u*)(P0 + (size_t)row * AB_IN + 768 + ch);
        float bgv[8] = {__uint_as_float(bg.x << 16), __uint_as_float(bg.x & 0xffff0000u), __uint_as_float(bg.y << 16), __uint_as_float(bg.y & 0xffff0000u),
                        __uint_as_float(bg.z << 16), __uint_as_float(bg.z & 0xffff0000u), __uint_as_float(bg.w << 16), __uint_as_float(bg.w & 0xffff0000u)};
        float o[8];
#pragma unroll
        for (int i = 0; i < 8; ++i) o[i] = bgv[i] * (w[ch + i] * u[2][i] + w[512 + ch + i] * u[1][i] + w[1024 + ch + i] * u[0][i]);
        *(v4u*)(MIX + (size_t)row * D + 512 + ch) = (v4u){pk2(o[0], o[1]), pk2(o[2], o[3]), pk2(o[4], o[5]), pk2(o[6], o[7])};
        const int last = samp ? TS : TP;
        if (pos >= last - 2) { float* sp = out + (samp ? O_CBS : O_CBP) + ((size_t)sq * 2 + (pos - (last - 2))) * 512 + ch; *(f32x4*)sp = (f32x4){u[0][0], u[0][1], u[0][2], u[0][3]}; *(f32x4*)(sp + 4) = (f32x4){u[0][4], u[0][5], u[0][6], u[0][7]}; }
    }
}

template <int BLK>
__device__ __forceinline__ void convc_block(const LAS bf16_t* utc, const float (&wt)[31], float (&win)[31], float (&ov)[64], float bias) {
#pragma unroll
    for (int p = 0; p < 31; ++p) { constexpr int base = 31 * BLK; const int si = base + p;
        if (si < 94) { win[p] = bf2f(utc[si * 512]);
            if (si >= 30) { float a = bias;
#pragma unroll
                for (int j = 0; j < 31; ++j) a += wt[j] * win[(p + 1 + j) % 31];
                ov[si - 30] = a; } } }
}
__device__ __forceinline__ void convc_tile(const Ctx& c, int T, const bf16_t* __restrict__ P1, const float* __restrict__ stc, const float* __restrict__ w, const float* __restrict__ cb, const float* __restrict__ lg, const float* __restrict__ lbv, bf16_t* __restrict__ MIX, float* __restrict__ out) {
    LAS bf16_t* ut = (LAS bf16_t*)c.lds;
    LAS float* stats = (LAS float*)(c.lds + 98304);
    int tid = c.tid; asm volatile("" : "+v"(tid));
    const int lane = tid & 63, wv_ = c.wave, ch = wv_ * 64 + lane;
    const bool samp = T >= NB * 65; const int sq = samp ? T - NB * 65 : T / 65, cc = samp ? 0 : T % 65, row0 = T * 64;
    const bool wstate = samp || cc == 64;
    __syncthreads();
    for (int it = tid; it < 94 * 64; it += NTHREADS) {
        const int si = it >> 6, c8 = (it & 63) * 8, ro = si - 30;
        float u[8];
        if (samp && ro < 0) { const float* sp = stc + ((size_t)sq * 30 + (30 + ro)) * 512 + c8;
#pragma unroll
            for (int i = 0; i < 8; ++i) u[i] = sp[i]; }
        else if (!samp && cc * 64 + ro < PADF) {
#pragma unroll
            for (int i = 0; i < 8; ++i) u[i] = 0.f; }
        else { const size_t r = (size_t)(row0 + ro) * CD_IN + c8; const v4u a = *(const v4u*)(P1 + r), g = *(const v4u*)(P1 + r + 512);
            u[0] = __uint_as_float(a.x << 16) * sigmoidf_(__uint_as_float(g.x << 16)); u[1] = __uint_as_float(a.x & 0xffff0000u) * sigmoidf_(__uint_as_float(g.x & 0xffff0000u));
            u[2] = __uint_as_float(a.y << 16) * sigmoidf_(__uint_as_float(g.y << 16)); u[3] = __uint_as_float(a.y & 0xffff0000u) * sigmoidf_(__uint_as_float(g.y & 0xffff0000u));
            u[4] = __uint_as_float(a.z << 16) * sigmoidf_(__uint_as_float(g.z << 16)); u[5] = __uint_as_float(a.z & 0xffff0000u) * sigmoidf_(__uint_as_float(g.z & 0xffff0000u));
            u[6] = __uint_as_float(a.w << 16) * sigmoidf_(__uint_as_float(g.w << 16)); u[7] = __uint_as_float(a.w & 0xffff0000u) * sigmoidf_(__uint_as_float(g.w & 0xffff0000u)); }
        *(LAS v4u*)(ut + si * 512 + c8) = (v4u){pk2(u[0], u[1]), pk2(u[2], u[3]), pk2(u[4], u[5]), pk2(u[6], u[7])};
        if (wstate && ro >= 34) { float* sp = out + (samp ? O_CCS : O_CCP) + ((size_t)sq * 30 + (ro - 34)) * 512 + c8; *(f32x4*)sp = (f32x4){u[0], u[1], u[2], u[3]}; *(f32x4*)(sp + 4) = (f32x4){u[4], u[5], u[6], u[7]}; }
    }
    __syncthreads();
    float wt[31], win[31], ov[64];
#pragma unroll
    for (int j = 0; j < 31; ++j) wt[j] = w[j * 512 + ch];
    const float bias = cb[ch];
    convc_block<0>(ut + ch, wt, win, ov, bias); convc_block<1>(ut + ch, wt, win, ov, bias); convc_block<2>(ut + ch, wt, win, ov, bias); convc_block<3>(ut + ch, wt, win, ov, bias);
    __syncthreads();
#pragma unroll
    for (int r = 0; r < 64; ++r) ut[r * 512 + ch] = f2bf(ov[r]);
    __syncthreads();
#pragma unroll
    for (int i = 0; i < 8; ++i) { const int r = wv_ * 8 + i; const v4u x = *(const LAS v4u*)(ut + r * 512 + lane * 8);
        const float x0 = __uint_as_float(x.x << 16), x1 = __uint_as_float(x.x & 0xffff0000u), x2 = __uint_as_float(x.y << 16), x3 = __uint_as_float(x.y & 0xffff0000u),
                    x4 = __uint_as_float(x.z << 16), x5 = __uint_as_float(x.z & 0xffff0000u), x6 = __uint_as_float(x.w << 16), x7 = __uint_as_float(x.w & 0xffff0000u);
        const float mu = wave_sum(((x0 + x1) + (x2 + x3)) + ((x4 + x5) + (x6 + x7))) * (1.0f / 512.0f);
        const float d0 = x0 - mu, d1 = x1 - mu, d2 = x2 - mu, d3 = x3 - mu, d4 = x4 - mu, d5 = x5 - mu, d6 = x6 - mu, d7 = x7 - mu;
        const float var = wave_sum(((d0 * d0 + d1 * d1) + (d2 * d2 + d3 * d3)) + ((d4 * d4 + d5 * d5) + (d6 * d6 + d7 * d7))) * (1.0f / 512.0f);
        if (lane == 0) { stats[2 * r] = mu; stats[2 * r + 1] = rsqrtf(var + 1e-5f); } }
    __syncthreads();
    const float gch = lg[ch], bch = lbv[ch];
#pragma unroll
    for (int r = 0; r < 64; ++r) { const float mu = stats[2 * r], rs = stats[2 * r + 1]; MIX[(size_t)(row0 + r) * D + ch] = f2bf(siluf_((ov[r] - mu) * rs * gch + bch)); }
}

constexpr int HG_UNITS = NTILE64 * 4;
constexpr size_t WS_US = WS_SPARE, WS_ATT = WS_WGU, WS_DEC = WS_WGU + (size_t)HG_UNITS * 8192;
static_assert((size_t)HG_UNITS * 32768 <= (size_t)MP * 512 * 4 && (size_t)HG_UNITS * (8192 + 512) <= (size_t)2 * FH * D * 2, "hgrn workspace");

__device__ __forceinline__ void hgrn_stage_vt(LAS bf16_t* VTs, const bf16_t* __restrict__ P1, int row0, int h, int tid) {
#pragma unroll 1
    for (int i = 0; i < 2; ++i) { const int cid = tid + 512 * i, t = cid >> 4, v0 = (cid & 15) * 8;
        const v4u rv = *(const v4u*)(P1 + (size_t)(row0 + t) * CD_IN + 2048 + h * 128 + v0);
        VTs[(v0 + 0) * 72 + t] = (bf16_t)(rv.x & 0xffffu); VTs[(v0 + 1) * 72 + t] = (bf16_t)(rv.x >> 16);
        VTs[(v0 + 2) * 72 + t] = (bf16_t)(rv.y & 0xffffu); VTs[(v0 + 3) * 72 + t] = (bf16_t)(rv.y >> 16);
        VTs[(v0 + 4) * 72 + t] = (bf16_t)(rv.z & 0xffffu); VTs[(v0 + 5) * 72 + t] = (bf16_t)(rv.z >> 16);
        VTs[(v0 + 6) * 72 + t] = (bf16_t)(rv.w & 0xffffu); VTs[(v0 + 7) * 72 + t] = (bf16_t)(rv.w >> 16); }
}

__device__ __forceinline__ void phase_hgrn_prep(const Ctx& c, bf16_t* P1, const float* __restrict__ lb, unsigned char* __restrict__ ws) {
    LAS bf16_t* Qs = (LAS bf16_t*)c.lds;
    LAS bf16_t* Ks = Qs + 64 * 136;
    LAS bf16_t* KDs = Ks + 64 * 136;
    LAS bf16_t* VTs = KDs + 128 * 72;
    LAS float* segtot = (LAS float*)(VTs + 128 * 72);
    const int w = c.wave;
    for (int u = blockIdx.x; u < HG_UNITS; u += c.G) {
        int tid = c.tid; asm volatile("" : "+v"(tid));
        const int k = tid & 127, seg = tid >> 7, lane = tid & 63, fr = lane & 15, fq = lane >> 4;
        const int T = u >> 2, h = u & 3, row0 = T * 64;
        const int npad = (T < NB * 65 && (T % 65) == 0) ? PADF : 0;
        const float lbv = lb[h * 128 + k];
        float cum[16], qv[16], kv[16];
        float run = 0.f;
#pragma unroll
        for (int i = 0; i < 16; ++i) { const int t = seg * 16 + i; const size_t r = (size_t)(row0 + t) * CD_IN + h * 128 + k;
            const float fg = lbv + (1.0f - lbv) * sigmoidf_(bf2f(P1[r + 1536])); const bool pad = t < npad;
            run += pad ? 0.f : __logf(fg); cum[i] = run; kv[i] = pad ? 0.f : 1.0f - fg; qv[i] = bf2f(P1[r + 1024]); }
        __syncthreads();
        segtot[seg * 128 + k] = run;
        hgrn_stage_vt(VTs, P1, row0, h, tid);
        __syncthreads();
        float off = 0.f, tot = 0.f;
#pragma unroll
        for (int s2 = 0; s2 < 4; ++s2) { const float v = segtot[s2 * 128 + k]; off += s2 < seg ? v : 0.f; tot += v; }
        unsigned kdp[8];
#pragma unroll
        for (int i = 0; i < 16; i += 2) {
            const int t = seg * 16 + i; const float c0 = cum[i] + off, c1 = cum[i + 1] + off;
            const bf16_t q0 = f2bf(qv[i] * __expf(c0)), q1 = f2bf(qv[i + 1] * __expf(c1));
            Qs[t * 136 + k] = q0; Qs[(t + 1) * 136 + k] = q1;
            P1[(size_t)(row0 + t) * CD_IN + 1024 + h * 128 + k] = q0; P1[(size_t)(row0 + t + 1) * CD_IN + 1024 + h * 128 + k] = q1;
            Ks[t * 136 + k] = f2bf(kv[i] * __expf(-c0)); Ks[(t + 1) * 136 + k] = f2bf(kv[i + 1] * __expf(-c1));
            kdp[i >> 1] = pk2(kv[i] * __expf(tot - c0), kv[i + 1] * __expf(tot - c1));
        }
        *(LAS v4u*)(KDs + k * 72 + seg * 16) = (v4u){kdp[0], kdp[1], kdp[2], kdp[3]};
        *(LAS v4u*)(KDs + k * 72 + seg * 16 + 8) = (v4u){kdp[4], kdp[5], kdp[6], kdp[7]};
        if (seg == 0) ((float*)(ws + WS_DEC))[(size_t)u * 128 + k] = __expf(tot);
        __syncthreads();
        const int tt = w >> 1;
        bf16_t* ATT = (bf16_t*)(ws + WS_ATT + (size_t)u * 8192);
#pragma unroll
        for (int si = 0; si < 2; ++si) { const int ss = (w & 1) * 2 + si; f32x4 acc = {0.f, 0.f, 0.f, 0.f};
#pragma unroll
            for (int ks = 0; ks < 4; ++ks) { const bf16x8 a = *(const LAS bf16x8*)(Qs + (16 * tt + fr) * 136 + 32 * ks + 8 * fq), b = *(const LAS bf16x8*)(Ks + (16 * ss + fr) * 136 + 32 * ks + 8 * fq);
                acc = __builtin_amdgcn_mfma_f32_16x16x32_bf16(b, a, acc, 0, 0, 0); }
            const int t = 16 * tt + fr, s0 = 16 * ss + 4 * fq;
            v2u o; o.x = pk2(s0 <= t ? acc[0] : 0.f, s0 + 1 <= t ? acc[1] : 0.f); o.y = pk2(s0 + 2 <= t ? acc[2] : 0.f, s0 + 3 <= t ? acc[3] : 0.f);
            *(v2u*)(ATT + t * 64 + s0) = o; }
        bf16_t* UT = (bf16_t*)(ws + WS_US + (size_t)u * 32768);
        bf16x8 bv[2];
#pragma unroll
        for (int s2 = 0; s2 < 2; ++s2) bv[s2] = *(const LAS bf16x8*)(VTs + (16 * w + fr) * 72 + 32 * s2 + 8 * fq);
#pragma unroll
        for (int kt = 0; kt < 8; ++kt) { f32x4 acc = {0.f, 0.f, 0.f, 0.f};
#pragma unroll
            for (int s2 = 0; s2 < 2; ++s2) { const bf16x8 a = *(const LAS bf16x8*)(KDs + (16 * kt + fr) * 72 + 32 * s2 + 8 * fq); acc = __builtin_amdgcn_mfma_f32_16x16x32_bf16(a, bv[s2], acc, 0, 0, 0); }
            v2u o; o.x = pk2(acc[0], acc[1]); o.y = pk2(acc[2], acc[3]);
            *(v2u*)(UT + (16 * w + fr) * 128 + 16 * kt + 4 * fq) = o; }
    }
    __syncthreads();
}

__device__ __forceinline__ void phase_hgrn_scan(const Ctx& c, unsigned char* __restrict__ ws, const float* __restrict__ st_in, float* __restrict__ out) {
    const float* DEC = (const float*)(ws + WS_DEC);
    for (int it = blockIdx.x * NTHREADS + c.tid; it < 16 * 8192; it += c.G * NTHREADS) {
        const int chain = it >> 13, v = (it >> 6) & 127, k = (it & 63) * 2, seq = chain >> 2, h = chain & 3;
        float s0 = 0.f, s1 = 0.f;
#pragma unroll 1
        for (int n0 = 0; n0 < 65; n0 += 5) {
            unsigned uu[5]; float d0[5], d1[5];
#pragma unroll
            for (int j = 0; j < 5; ++j) { const size_t u = (size_t)(seq * 65 + n0 + j) * 4 + h; uu[j] = *(const unsigned*)(ws + WS_US + u * 32768 + (size_t)(v * 128 + k) * 2);
                const v2u dd = *(const v2u*)(DEC + u * 128 + k); d0[j] = __uint_as_float(dd.x); d1[j] = __uint_as_float(dd.y); }
#pragma unroll
            for (int j = 0; j < 5; ++j) { const size_t u = (size_t)(seq * 65 + n0 + j) * 4 + h;
                *(unsigned*)(ws + WS_US + u * 32768 + (size_t)(v * 128 + k) * 2) = pk2(s0, s1);
                s0 = d0[j] * s0 + __uint_as_float(uu[j] << 16); s1 = d1[j] * s1 + __uint_as_float(uu[j] & 0xffff0000u); }
        }
        float* op = out + O_HGP + (size_t)chain * 16384 + (size_t)k * 128 + v; op[0] = s0; op[128] = s1;
    }
    for (int it = blockIdx.x * NTHREADS + c.tid; it < 32 * 8192; it += c.G * NTHREADS) {
        const int chain = it >> 13, v = (it >> 6) & 127, k = (it & 63) * 2, sq = chain >> 2, h = chain & 3;
        const size_t u = (size_t)(NB * 65 + sq) * 4 + h;
        const float* sp = st_in + (size_t)chain * 16384 + (size_t)k * 128 + v; const float s0 = sp[0], s1 = sp[128];
        unsigned* up = (unsigned*)(ws + WS_US + u * 32768 + (size_t)(v * 128 + k) * 2); const unsigned uu = *up; *up = pk2(s0, s1);
        const v2u dd = *(const v2u*)(DEC + u * 128 + k);
        float* op = out + O_HGS + (size_t)chain * 16384 + (size_t)k * 128 + v;
        op[0] = __uint_as_float(dd.x) * s0 + __uint_as_float(uu << 16); op[128] = __uint_as_float(dd.y) * s1 + __uint_as_float(uu & 0xffff0000u);
    }
}

__device__ __forceinline__ void hgrn_out_unit(const Ctx& c, int u, const bf16_t* __restrict__ P1, const unsigned char* __restrict__ ws, const float* __restrict__ ng, bf16_t* __restrict__ MIX) {
    LAS bf16_t* Qs = (LAS bf16_t*)c.lds;
    LAS bf16_t* ATs = Qs + 64 * 136;
    LAS bf16_t* VTs = ATs + 64 * 72;
    LAS float* PART = (LAS float*)(VTs + 128 * 72);
    int tid = c.tid; asm volatile("" : "+v"(tid));
    const int lane = tid & 63, w = c.wave, fr = lane & 15, fq = lane >> 4;
    const int T = u >> 2, h = u & 3, row0 = T * 64;
    __syncthreads();
#pragma unroll 1
    for (int i = 0; i < 2; ++i) { const int cid = tid + 512 * i, t = cid >> 4, pc = cid & 15;
        *(LAS v4u*)(Qs + t * 136 + pc * 8) = *(const v4u*)(P1 + (size_t)(row0 + t) * CD_IN + 1024 + h * 128 + pc * 8); }
    *(LAS v4u*)(ATs + (tid >> 3) * 72 + (tid & 7) * 8) = *(const v4u*)((const bf16_t*)(ws + WS_ATT + (size_t)u * 8192) + tid * 8);
    hgrn_stage_vt(VTs, P1, row0, h, tid);
    bf16x8 sb[4];
#pragma unroll
    for (int ks = 0; ks < 4; ++ks) sb[ks] = *(const bf16x8*)((const bf16_t*)(ws + WS_US + (size_t)u * 32768) + (16 * w + fr) * 128 + 32 * ks + 8 * fq);
    bf16_t gv[16];
#pragma unroll
    for (int tt = 0; tt < 4; ++tt)
#pragma unroll
        for (int r = 0; r < 4; ++r) gv[tt * 4 + r] = P1[(size_t)(row0 + 16 * tt + 4 * fq + r) * CD_IN + 2560 + h * 128 + 16 * w + fr];
    const float ngv = ng[h * 128 + 16 * w + fr];
    __syncthreads();
    bf16x8 bv[2];
#pragma unroll
    for (int s2 = 0; s2 < 2; ++s2) bv[s2] = *(const LAS bf16x8*)(VTs + (16 * w + fr) * 72 + 32 * s2 + 8 * fq);
    f32x4 o[4];
#pragma unroll
    for (int tt = 0; tt < 4; ++tt) o[tt] = (f32x4){0.f, 0.f, 0.f, 0.f};
#pragma unroll
    for (int ks = 0; ks < 4; ++ks)
#pragma unroll
        for (int tt = 0; tt < 4; ++tt) { const bf16x8 a = *(const LAS bf16x8*)(Qs + (16 * tt + fr) * 136 + 32 * ks + 8 * fq); o[tt] = __builtin_amdgcn_mfma_f32_16x16x32_bf16(a, sb[ks], o[tt], 0, 0, 0); }
#pragma unroll
    for (int s2 = 0; s2 < 2; ++s2)
#pragma unroll
        for (int tt = 0; tt < 4; ++tt) { const bf16x8 a = *(const LAS bf16x8*)(ATs + (16 * tt + fr) * 72 + 32 * s2 + 8 * fq); o[tt] = __builtin_amdgcn_mfma_f32_16x16x32_bf16(a, bv[s2], o[tt], 0, 0, 0); }
#pragma unroll
    for (int tt = 0; tt < 4; ++tt)
#pragma unroll
        for (int r = 0; r < 4; ++r) { float q2 = o[tt][r] * o[tt][r]; q2 += __shfl_xor(q2, 1); q2 += __shfl_xor(q2, 2); q2 += __shfl_xor(q2, 4); q2 += __shfl_xor(q2, 8);
            if (fr == 0) PART[(16 * tt + 4 * fq + r) * 8 + w] = q2; }
    __syncthreads();
#pragma unroll
    for (int tt = 0; tt < 4; ++tt)
#pragma unroll
        for (int r = 0; r < 4; ++r) { const int t = 16 * tt + 4 * fq + r; const f32x4 p0 = *(const LAS f32x4*)(PART + t * 8), p1 = *(const LAS f32x4*)(PART + t * 8 + 4);
            const float ssum = ((p0[0] + p0[1]) + (p0[2] + p0[3])) + ((p1[0] + p1[1]) + (p1[2] + p1[3]));
            const float val = o[tt][r] * rsqrtf(ssum * (1.0f / 128.0f) + 1e-6f) * ngv * siluf_(bf2f(gv[tt * 4 + r]));
            MIX[(size_t)(row0 + t) * D + 512 + h * 128 + 16 * w + fr] = f2bf(val); }
}

struct Params { const float* in[28]; float* out; unsigned char* ws; };
typedef __attribute__((address_space(4))) const unsigned long long kconst_u64;
__device__ __forceinline__ unsigned long long karg_raw(int i) { kconst_u64* kp = (kconst_u64*)__builtin_amdgcn_kernarg_segment_ptr(); asm volatile("" : "+s"(kp)); return kp[i]; }
#define GASP __attribute__((address_space(1)))
#define KIN(i) ((const float*)(const GASP float*)karg_raw(i))
#define KOUT() ((float*)(GASP float*)karg_raw(28))
#define KWS() ((unsigned char*)(GASP unsigned char*)karg_raw(29))
#define FRESH_CTX(c) Ctx c; { int t_ = threadIdx.x; asm volatile("" : "+v"(t_)); c.lds = (LAS unsigned char*)lds_raw; c.tid = t_; c.lane = t_ & 63; c.wave = __builtin_amdgcn_readfirstlane(t_ >> 6); \
        c.G = gridDim.x; c.gw = blockIdx.x * NWAVES + c.wave; c.NGW = c.G * NWAVES; }
#define GEMM_PHASE(EPI, A_, B_, N_, K_, ...) do { unsigned char* ws_ = KWS(); pg8::Gemm g_{(const bf16_t*)(ws_ + (A_)), (const bf16_t*)(ws_ + (B_)), MP, (N_), (K_)}; pg8::StaticOrder S_; S_.init(MP, (N_), (int)gridDim.x, (int)blockIdx.x); \
        EPI E_{__VA_ARGS__}; pg8::gemm_phase<EPI, pg8::StaticOrder, true, true>((LAS unsigned char*)lds_raw, g_, S_, E_); } while (0)

#define LAYER_TAIL(L) do { \
    GEMM_PHASE(pg8::EpiF32, WS_MIX, ((L) == 0 ? WS_WAB_O : WS_WCD_O), D, D, (float*)(ws_ + WS_P), D); \
    GRID_BAR(); \
    { FRESH_CTX(cc); unsigned char* ws = KWS(); phase_ln_residual(cc, (bf16_t*)(ws + WS_HB), (const float*)(ws + WS_P), KIN(22) + (L) * D, KIN(23) + (L) * D, nullptr); } \
    GRID_BAR(); \
    GEMM_PHASE(pg8::EpiGU, WS_HB, WS_WGU + (size_t)(L) * 2 * FH * D * 2, 2 * FH, D, (bf16_t*)(ws_ + WS_P), FH); \
    GRID_BAR(); \
    GEMM_PHASE(pg8::EpiF32, WS_P, WS_WDN + (size_t)(L) * D * FH * 2, D, FH, (float*)(ws_ + WS_MIX), D); \
    GRID_BAR(); \
    { FRESH_CTX(cc); unsigned char* ws = KWS(); phase_ln_residual(cc, (bf16_t*)(ws + WS_HB), (const float*)(ws + WS_MIX), KIN(24) + (L) * D, KIN(25) + (L) * D, (L) == 1 ? KOUT() : nullptr); } \
    } while (0)

__global__ void __launch_bounds__(NTHREADS) fwd_megakernel(Params p) {
    extern __shared__ __attribute__((aligned(16))) unsigned char lds_raw[];
    volatile LAS unsigned* ctl = (volatile LAS unsigned*)((LAS unsigned char*)lds_raw + LDSCTL_OFF);
    if (threadIdx.x < 64) ctl[threadIdx.x] = 0u;
    __syncthreads();
    XcdBarrier bar = xcd_barrier_post((unsigned*)(KWS() + WS_CTL) + CW_BAR, ctl + 8);
#define GRID_BAR() do { bar.bar = (unsigned*)(KWS() + WS_CTL) + CW_BAR; xcd_barrier(bar); } while (0)

    { FRESH_CTX(cc); phase_prologue(cc, p.in, KWS()); }
    GRID_BAR();
    GEMM_PHASE(pg8::EpiBf16<0>, WS_HB, WS_WAB_IN, AB_IN, D, (bf16_t*)(ws_ + WS_P), AB_IN, KIN(9), 0, 0, 1.f);
    GRID_BAR();
    { FRESH_CTX(cc); unsigned char* ws = KWS(); phase_attn(cc, (const bf16_t*)(ws + WS_P), KIN(2), KIN(3), KIN(10), (bf16_t*)(ws + WS_MIX), KOUT()); }
    { FRESH_CTX(cc); unsigned char* ws = KWS(); phase_convb(cc, (const bf16_t*)(ws + WS_P), KIN(4), KIN(11), (bf16_t*)(ws + WS_MIX), KOUT()); }
    GRID_BAR();
    LAYER_TAIL(0);
    GRID_BAR();
    GEMM_PHASE(pg8::EpiBf16<0>, WS_HB, WS_WCD_IN, CD_IN, D, (bf16_t*)(ws_ + WS_P), CD_IN, KIN(14), 0, 0, 1.f);
    GRID_BAR();
    { FRESH_CTX(cc); unsigned char* ws = KWS(); phase_hgrn_prep(cc, (bf16_t*)(ws + WS_P), (const float*)(ws + WS_LB), ws); }
    GRID_BAR();
    { FRESH_CTX(cc); unsigned char* ws = KWS(); phase_hgrn_scan(cc, ws, KIN(6), KOUT()); }
    { FRESH_CTX(cc); unsigned char* ws = KWS(); const float* stc = KIN(5); const float* cw = KIN(15); const float* cb = KIN(16); const float* lg = KIN(17); const float* lbv = KIN(18); float* out = KOUT();
        for (int T = (int)blockIdx.x; T < NTILE64; T += cc.G) convc_tile(cc, T, (const bf16_t*)(ws + WS_P), stc, cw, cb, lg, lbv, (bf16_t*)(ws + WS_MIX), out); }
    GRID_BAR();
    { FRESH_CTX(cc); unsigned char* ws = KWS(); const float* ng = KIN(20);
        for (int u = (int)blockIdx.x; u < HG_UNITS; u += cc.G) hgrn_out_unit(cc, u, (const bf16_t*)(ws + WS_P), ws, ng, (bf16_t*)(ws + WS_MIX)); }
    GRID_BAR();
    LAYER_TAIL(1);
}

extern "C" void kernel_launch(void* const* d_in, const int* in_sizes, int n_in, void* d_out, int out_size, void* d_ws, size_t ws_size, hipStream_t stream) {
    static int grid = 0;
    if (grid == 0) {
        if (n_in != 28 || ws_size < WS_END) { fprintf(stderr, "kernel_launch: unexpected n_in %d / ws_size %zu (need %zu)\n", n_in, ws_size, (size_t)WS_END); grid = -1; return; }
        int dev = 0, cus = 0, per_cu = 0;
        if (hipGetDevice(&dev) != hipSuccess || hipDeviceGetAttribute(&cus, hipDeviceAttributeMultiprocessorCount, dev) != hipSuccess) { grid = -1; return; }
        if (hipFuncSetAttribute((const void*)fwd_megakernel, hipFuncAttributeMaxDynamicSharedMemorySize, LDS_BYTES) != hipSuccess) { fprintf(stderr, "kernel_launch: hipFuncSetAttribute failed\n"); grid = -1; return; }
        if (hipOccupancyMaxActiveBlocksPerMultiprocessor(&per_cu, (const void*)fwd_megakernel, NTHREADS, LDS_BYTES) != hipSuccess || per_cu < 1) { fprintf(stderr, "kernel_launch: occupancy query says %d blocks per CU\n", per_cu); (void)hipGetLastError(); per_cu = 1; }
        grid = cus;
    }
    if (grid < 0) return;
    (void)hipMemsetAsync((char*)d_ws + WS_CTL, 0, CTL_ZERO_BYTES, stream);
    Params p{};
    for (int i = 0; i < 28; ++i) p.in[i] = (const float*)d_in[i];
    p.out = (float*)d_out; p.ws = (unsigned char*)d_ws;
    hipLaunchKernelGGL(fwd_megakernel, dim3(grid), dim3(NTHREADS), LDS_BYTES, stream, p);
}
```
